# Optimizing an MI355X kernel written in HIP

```python
import math
import jax, jax.numpy as jnp
from jax import lax
import numpy as np

D_MODEL = 1024
BATCH = 8
SEQ = 4096
DEPTH = 4

SSM_WIDTH = D_MODEL // 2
SSM_GROUP = 16
SSM_GROUPS = SSM_WIDTH // SSM_GROUP
SSM_STATE = 64
ATTN_WIDTH = D_MODEL - SSM_WIDTH
ATTN_HEAD_DIM = 64
ATTN_HEADS = ATTN_WIDTH // (2 * ATTN_HEAD_DIM)
IN_COLS = SSM_WIDTH + 3 * ATTN_WIDTH
D_FF = 2752
N_EXPERTS = 8
TOP_K = 2
D_FF_EXPERT = 3584
N_DENSE = (DEPTH + 1) // 2
N_MOE = DEPTH // 2
Q_BLOCK = 128
NORM_EPS = 1e-6
STEP_MIN = 1e-3
STEP_MAX = 1e-1

kernel_name = "hymba_style_s5_diffattn_moe_encoder"


def rmsnorm(x, g):
    x32 = x.astype(jnp.float32)
    y = x32 * lax.rsqrt(jnp.mean(x32 * x32, axis=-1, keepdims=True) + NORM_EPS)
    return (y * g.astype(jnp.float32)).astype(x.dtype)


def swiglu(h, w_gate, w_up, w_down):
    return (jax.nn.silu(h @ w_gate) * (h @ w_up)) @ w_down


def alibi_slopes(n_heads):
    return 2.0 ** (-8.0 * jnp.arange(1, n_heads + 1, dtype=jnp.float32) / n_heads)


def _scan_combine(e1, e2):
    a1, b1 = e1
    a2, b2 = e2
    return a1 * a2, a2 * b1 + b2


def ssm_direction(u_c, lam_re, lam_im, log_step, b_re, b_im, c_re, c_im, reverse):
    f32 = jnp.float32
    lam = lax.complex(lam_re.astype(f32), lam_im.astype(f32))
    step = jnp.exp(log_step.astype(f32))[:, None]
    lam_bar = jnp.exp(lam * step)
    b = lax.complex(b_re.astype(f32), b_im.astype(f32))
    b_bar = ((lam_bar - 1.0) / lam)[:, :, None] * b
    c = lax.complex(c_re.astype(f32), c_im.astype(f32))
    bu = jnp.einsum('blgh,gph->blgp', u_c, b_bar)
    a = jnp.broadcast_to(lam_bar, (1, bu.shape[1]) + lam_bar.shape)
    _, states = lax.associative_scan(_scan_combine, (a, bu), reverse=reverse, axis=1)
    return jnp.real(jnp.einsum('blgp,ghp->blgh', states, c))


def ssm_mixer(u, lam_re, lam_im, log_step, b_re, b_im, c_re, c_im, d_skip, w_glu, b_glu, g_out):
    bsz, seq, _ = u.shape
    u32 = u.astype(jnp.float32)
    u_c = u32.reshape(bsz, seq, SSM_GROUPS, SSM_GROUP).astype(jnp.complex64)
    y = u32 * d_skip.astype(jnp.float32)
    for direction, reverse in ((0, False), (1, True)):
        y = y + ssm_direction(u_c, lam_re[direction], lam_im[direction], log_step[direction],
                              b_re[direction], b_im[direction], c_re[direction], c_im[direction],
                              reverse).reshape(bsz, seq, SSM_WIDTH)
    y = jax.nn.gelu(y).astype(u.dtype)
    y = y * jax.nn.sigmoid(y @ w_glu + b_glu)
    return rmsnorm(y, g_out)


def diff_attention(q, k, v, lq1, lk1, lq2, lk2, g_subln, lambda_init):
    f32 = jnp.float32
    bsz, seq, _ = q.shape
    scale = ATTN_HEAD_DIM ** -0.5
    qh = q.astype(f32).reshape(bsz, seq, ATTN_HEADS, 2, ATTN_HEAD_DIM) * scale
    kh = k.astype(f32).reshape(bsz, seq, ATTN_HEADS, 2, ATTN_HEAD_DIM)
    vh = v.astype(f32).reshape(bsz, seq, ATTN_HEADS, 2 * ATTN_HEAD_DIM)
    k1, k2 = kh[..., 0, :], kh[..., 1, :]
    lam = (jnp.exp(jnp.sum(lq1.astype(f32) * lk1.astype(f32)))
           - jnp.exp(jnp.sum(lq2.astype(f32) * lk2.astype(f32))) + lambda_init)
    slopes = alibi_slopes(ATTN_HEADS)
    pos = jnp.arange(seq, dtype=f32)
    n_blocks = seq // Q_BLOCK
    q_blocks = qh.reshape(bsz, n_blocks, Q_BLOCK, ATTN_HEADS, 2, ATTN_HEAD_DIM).transpose(1, 0, 2, 3, 4, 5)
    pos_blocks = pos.reshape(n_blocks, Q_BLOCK)

    def one_block(xs):
        q_blk, p_blk = xs
        bias = -slopes[:, None, None] * jnp.abs(p_blk[:, None] - pos[None, :])
        s1 = jnp.einsum('bqhd,bkhd->bhqk', q_blk[..., 0, :], k1) + bias
        s2 = jnp.einsum('bqhd,bkhd->bhqk', q_blk[..., 1, :], k2) + bias
        attn = jax.nn.softmax(s1, axis=-1) - lam * jax.nn.softmax(s2, axis=-1)
        return jnp.einsum('bhqk,bkhe->bqhe', attn, vh)

    o = lax.map(one_block, (q_blocks, pos_blocks))
    o = o.transpose(1, 0, 2, 3, 4).reshape(bsz, seq, ATTN_HEADS, 2 * ATTN_HEAD_DIM)
    o = rmsnorm(o, g_subln) * (1.0 - lambda_init)
    return o.reshape(bsz, seq, ATTN_WIDTH).astype(q.dtype)


def moe_swiglu(h, w_router, b_router, w_gate, w_up, w_down):
    bsz, seq, dm = h.shape
    t = h.reshape(-1, dm)
    logits = (t @ w_router).astype(jnp.float32) + b_router.astype(jnp.float32)
    top_vals, top_idx = lax.top_k(logits, TOP_K)
    top_w = jax.nn.softmax(top_vals, axis=-1)
    gates = jnp.einsum('nk,nke->ne', top_w,
                       jax.nn.one_hot(top_idx, N_EXPERTS, dtype=jnp.float32)).astype(h.dtype)
    out = jnp.zeros_like(t)
    for e in range(N_EXPERTS):
        out = out + gates[:, e:e + 1] * swiglu(t, w_gate[e], w_up[e], w_down[e])
    return out.reshape(bsz, seq, dm)


def setup_inputs(seed: int = 0) -> dict:
    key = jax.random.key(seed)
    ks = jax.random.split(key, 40)
    f32 = jnp.float32
    nrm = lambda k, shape, s: jax.random.normal(k, shape, f32) * s
    gain = lambda k, shape: 1.0 + 0.02 * jax.random.normal(k, shape, f32)
    n_idx = jnp.arange(SSM_STATE, dtype=f32)
    lam_shape = (DEPTH, 2, SSM_GROUPS, SSM_STATE)
    return {
        "x": jax.random.normal(ks[0], (BATCH, SEQ, D_MODEL), f32),
        "g_mix": gain(ks[1], (DEPTH, D_MODEL)),
        "w_in": nrm(ks[2], (DEPTH, D_MODEL, IN_COLS), D_MODEL ** -0.5),
        "ssm_lambda_re": -0.5 + 0.01 * jax.random.normal(ks[3], lam_shape, f32),
        "ssm_lambda_im": math.pi * n_idx + 0.01 * jax.random.normal(ks[4], lam_shape, f32),
        "ssm_log_step": jax.random.uniform(ks[5], (DEPTH, 2, SSM_GROUPS), f32,
                                           math.log(STEP_MIN), math.log(STEP_MAX)),
        "ssm_b_re": nrm(ks[6], (DEPTH, 2, SSM_GROUPS, SSM_STATE, SSM_GROUP), (2.0 * SSM_GROUP) ** -0.5),
        "ssm_b_im": nrm(ks[7], (DEPTH, 2, SSM_GROUPS, SSM_STATE, SSM_GROUP), (2.0 * SSM_GROUP) ** -0.5),
        "ssm_c_re": nrm(ks[8], (DEPTH, 2, SSM_GROUPS, SSM_GROUP, SSM_STATE), (2.0 * SSM_STATE) ** -0.5),
        "ssm_c_im": nrm(ks[9], (DEPTH, 2, SSM_GROUPS, SSM_GROUP, SSM_STATE), (2.0 * SSM_STATE) ** -0.5),
        "ssm_d": nrm(ks[10], (DEPTH, SSM_WIDTH), 1.0),
        "w_glu": nrm(ks[11], (DEPTH, SSM_WIDTH, SSM_WIDTH), SSM_WIDTH ** -0.5),
        "b_glu": nrm(ks[12], (DEPTH, SSM_WIDTH), 0.02),
        "g_ssm_out": gain(ks[13], (DEPTH, SSM_WIDTH)),
        "lambda_q1": nrm(ks[14], (DEPTH, ATTN_HEAD_DIM), 0.1),
        "lambda_k1": nrm(ks[15], (DEPTH, ATTN_HEAD_DIM), 0.1),
        "lambda_q2": nrm(ks[16], (DEPTH, ATTN_HEAD_DIM), 0.1),
        "lambda_k2": nrm(ks[17], (DEPTH, ATTN_HEAD_DIM), 0.1),
        "g_subln": gain(ks[18], (DEPTH, 2 * ATTN_HEAD_DIM)),
        "w_out": nrm(ks[19], (DEPTH, D_MODEL, D_MODEL), D_MODEL ** -0.5),
        "g_ffn": gain(ks[20], (DEPTH, D_MODEL)),
        "dense_w_gate": nrm(ks[21], (N_DENSE, D_MODEL, D_FF), D_MODEL ** -0.5),
        "dense_w_up": nrm(ks[22], (N_DENSE, D_MODEL, D_FF), D_MODEL ** -0.5),
        "dense_w_down": nrm(ks[23], (N_DENSE, D_FF, D_MODEL), D_FF ** -0.5),
        "w_router": nrm(ks[24], (N_MOE, D_MODEL, N_EXPERTS), D_MODEL ** -0.5),
        "b_router": nrm(ks[25], (N_MOE, N_EXPERTS), 0.01),
        "moe_w_gate": nrm(ks[26], (N_MOE, N_EXPERTS, D_MODEL, D_FF_EXPERT), D_MODEL ** -0.5),
        "moe_w_up": nrm(ks[27], (N_MOE, N_EXPERTS, D_MODEL, D_FF_EXPERT), D_MODEL ** -0.5),
        "moe_w_down": nrm(ks[28], (N_MOE, N_EXPERTS, D_FF_EXPERT, D_MODEL), D_FF_EXPERT ** -0.5),
        "g_final": gain(ks[29], (D_MODEL,)),
    }


def reference(x, g_mix, w_in, ssm_lambda_re, ssm_lambda_im, ssm_log_step, ssm_b_re, ssm_b_im,
              ssm_c_re, ssm_c_im, ssm_d, w_glu, b_glu, g_ssm_out, lambda_q1, lambda_k1,
              lambda_q2, lambda_k2, g_subln, w_out, g_ffn, dense_w_gate, dense_w_up,
              dense_w_down, w_router, b_router, moe_w_gate, moe_w_up, moe_w_down, g_final):
    splits = [SSM_WIDTH, SSM_WIDTH + ATTN_WIDTH, SSM_WIDTH + 2 * ATTN_WIDTH]
    for i in range(DEPTH):
        lambda_init = 0.8 - 0.6 * math.exp(-0.3 * i)
        h = rmsnorm(x, g_mix[i])
        z = h @ w_in[i]
        u, q, k, v = jnp.split(z, splits, axis=-1)
        y_ssm = ssm_mixer(u, ssm_lambda_re[i], ssm_lambda_im[i], ssm_log_step[i],
                          ssm_b_re[i], ssm_b_im[i], ssm_c_re[i], ssm_c_im[i],
                          ssm_d[i], w_glu[i], b_glu[i], g_ssm_out[i])
        y_att = diff_attention(q, k, v, lambda_q1[i], lambda_k1[i], lambda_q2[i], lambda_k2[i],
                               g_subln[i], lambda_init)
        x = x + jnp.concatenate([y_ssm, y_att], axis=-1) @ w_out[i]
        h = rmsnorm(x, g_ffn[i])
        if i % 2 == 0:
            j = i // 2
            x = x + swiglu(h, dense_w_gate[j], dense_w_up[j], dense_w_down[j])
        else:
            j = i // 2
            x = x + moe_swiglu(h, w_router[j], b_router[j], moe_w_gate[j], moe_w_up[j], moe_w_down[j])
    return rmsnorm(x, g_final)
```

```cpp
#include <hip/hip_runtime.h>
#include <hip/hip_bf16.h>
#include <cstdio>
#include <cstdint>
#include <cmath>

constexpr int BATCH = 8, SEQ = 4096, DM = 1024, DEPTH = 4;
constexpr int M = BATCH * SEQ;
constexpr int SSM_W = 512, SSM_G = 32, SSM_GC = 16, SSM_P = 64;
constexpr int ATT_W = 512, ATT_H = 4, ATT_D = 64, ATT_DV = 128;
constexpr int IN_COLS = 2048;
constexpr int DFF = 2752, DFF_P = 2816;
constexpr int NEXP = 8, DFE = 3584;
constexpr float NORM_EPS = 1e-6f;
constexpr float QSCALE = 0.125f * 1.4426950408889634f;
constexpr float SS_FX = 16777216.0f, SS_FX_INV = 1.0f / 16777216.0f;

namespace pg8 {
#define PG8_LAS __attribute__((address_space(3)))
typedef unsigned short bf16_t;
typedef short bf16x8 __attribute__((ext_vector_type(8)));
typedef float f32x4 __attribute__((ext_vector_type(4)));
typedef float f32x2 __attribute__((ext_vector_type(2)));
typedef unsigned u32x4 __attribute__((ext_vector_type(4)));
typedef unsigned u32x2 __attribute__((ext_vector_type(2)));
constexpr int BM = 256, BK = 64, HALF = 128, HTB = HALF * BK * 2  , STAGE_BYTES = 8 * HTB, NXCD = 8, WGM = 8;

__host__ __device__ __forceinline__ int lds_byte(int r, int c) { const int st = (r >> 4) * 2 + (c >> 5), rr = r & 15, cc = c & 31, ob = rr * 64 + cc * 2; return st * 1024 + (ob ^ (((ob >> 9) & 1) << 5)); }
__host__ __device__ __forceinline__ void stage_rc(int b, int& R, int& C) { const int st = b / 1024, sb = b % 1024, swz = sb ^ (((sb >> 9) & 1) << 5); R = (st >> 1) * 16 + swz / 64; C = (st & 1) * 32 + (swz % 64) / 2; }
__host__ __device__ __forceinline__ int perm32(int rho) { const int n = rho >> 4, i = rho & 15; return 8 * (i >> 2) + 4 * n + (i & 3); }

struct Unit { int pm, pn, e; };
struct Gemm { const bf16_t* A; const bf16_t* Bt; int M, N, K; size_t be; };

struct StaticOrder {
    int nM, nN, nwg, G, c;
    __host__ __device__ void init(int M_, int N_, int G_, int c_) { nM = M_ / BM; nN = N_ / BM; nwg = nM * nN; G = G_; c = c_; }
    __host__ __device__ bool next(int i, Unit& u) const {
        const long L = (long)i * G + c; if (L >= nwg) return false;
        int wgid = (int)L; { const int q = nwg / NXCD, r = nwg % NXCD, xcd = wgid % NXCD, off = wgid / NXCD; wgid = (xcd < r ? xcd * (q + 1) : r * (q + 1) + (xcd - r) * q) + off; }
        const int nig = WGM * nN, gid = wgid / nig, fm = gid * WGM, gsz = (nM - fm) < WGM ? (nM - fm) : WGM;
        u.pm = fm + ((wgid % nig) % gsz); u.pn = (wgid % nig) / gsz; u.e = 0; return true;
    }
    __device__ __forceinline__ void a_ready(const Unit&) const {}
    __device__ __forceinline__ void done(const Unit&) const {}
};
struct ChunkOrder {
    int nM, nN, nwg, G, c, tlo; int toff[9];
    __device__ bool next(int i, Unit& u) const {
        const long L = (long)i * G + c; if (L >= nwg) return false;
        int wgid = (int)L; { const int q = nwg / NXCD, r = nwg % NXCD, xcd = wgid % NXCD, off = wgid / NXCD; wgid = (xcd < r ? xcd * (q + 1) : r * (q + 1) + (xcd - r) * q) + off; }
        const int nig = WGM * nN, gid = wgid / nig, fm = gid * WGM, gsz = (nM - fm) < WGM ? (nM - fm) : WGM;
        u.pm = tlo + fm + ((wgid % nig) % gsz); u.pn = (wgid % nig) / gsz;
        int e = 0;
#pragma unroll
        for (int k = 1; k < 8; ++k) e += (u.pm >= toff[k]) ? 1 : 0;
        u.e = e; return true;
    }
    __device__ __forceinline__ void a_ready(const Unit&) const {}
    __device__ __forceinline__ void done(const Unit&) const {}
};

__device__ __forceinline__ unsigned cvt_pk_bf16(float lo, float hi) { unsigned r; asm volatile("v_cvt_pk_bf16_f32 %0, %1, %2" : "=v"(r) : "v"(lo), "v"(hi)); return r; }
__device__ __forceinline__ float bf_lo(unsigned w) { return __uint_as_float(w << 16); }
__device__ __forceinline__ float bf_hi(unsigned w) { return __uint_as_float(w & 0xffff0000u); }
__device__ __forceinline__ float rs_from_ss(const unsigned long long* ss, int row, float inv_n) {
    const unsigned long long v = ss[row];
    return 1.0f / sqrtf((float)v * SS_FX_INV * inv_n + NORM_EPS);
}
__device__ __forceinline__ void ss_add(unsigned long long* ss, int row, float part) {
    __hip_atomic_fetch_add(ss + row, (unsigned long long)(part * SS_FX), __ATOMIC_RELAXED, __HIP_MEMORY_SCOPE_AGENT);
}
__device__ __forceinline__ float sum4sq(f32x4 v) { return (v[0] * v[0] + v[1] * v[1]) + (v[2] * v[2] + v[3] * v[3]); }

struct EpiInProj {
    static constexpr bool PERM = true, AFTER_DRAIN = false;
    bf16_t* Ug; bf16_t* Q; size_t qkv_stride; const unsigned long long* ss;
    __device__ __forceinline__ void operator()(const f32x4 (&acc)[2][2][4][2], const Unit& u, int wr, int wc, int fr, int fq) const {
        const int row0 = u.pm * BM + wr * 64 + fr, ct = u.pn;
#pragma unroll
        for (int ai = 0; ai < 2; ++ai)
#pragma unroll
            for (int m = 0; m < 4; ++m) { const int row = row0 + ai * HALF + m * 16; const float rs = rs_from_ss(ss, row, 1.0f / DM);
#pragma unroll
                for (int bj = 0; bj < 2; ++bj) { const f32x4 v0 = acc[ai][bj][m][0] * rs, v1 = acc[ai][bj][m][1] * rs;
                    u32x4 w; w.x = cvt_pk_bf16(v0[0], v0[1]); w.y = cvt_pk_bf16(v0[2], v0[3]); w.z = cvt_pk_bf16(v1[0], v1[1]); w.w = cvt_pk_bf16(v1[2], v1[3]);
                    const int c0 = (ct & 1) * 256 + bj * HALF + wc * 32 + 8 * fq;
                    bf16_t* dst;
                    if (ct < 2) dst = Ug + ((size_t)(c0 >> 4) * M + row) * 16 + (c0 & 15);
                    else dst = Q + (size_t)((ct >> 1) - 1) * qkv_stride + (size_t)row * 512 + c0;
                    *(u32x4*)dst = w; }
                asm volatile("" ::: "memory"); }
    }
};
struct EpiGLU {
    static constexpr bool PERM = true, AFTER_DRAIN = false;
    const bf16_t* Y; bf16_t* MIX; const float* bias; unsigned long long* ss;
    __device__ __forceinline__ void operator()(const f32x4 (&acc)[2][2][4][2], const Unit& u, int wr, int wc, int fr, int fq) const {
        const int row0 = u.pm * BM + wr * 64 + fr;
#pragma unroll
        for (int ai = 0; ai < 2; ++ai)
#pragma unroll
            for (int m = 0; m < 4; ++m) { const int row = row0 + ai * HALF + m * 16; float part = 0.f;
#pragma unroll
                for (int bj = 0; bj < 2; ++bj) { const int c0 = u.pn * BM + bj * HALF + wc * 32 + 8 * fq;
                    const f32x4 b0 = *(const f32x4*)(bias + c0), b1 = *(const f32x4*)(bias + c0 + 4);
                    const u32x4 yw = *(const u32x4*)(Y + (size_t)row * 512 + c0);
                    const f32x4 y0 = {bf_lo(yw.x), bf_hi(yw.x), bf_lo(yw.y), bf_hi(yw.y)}, y1 = {bf_lo(yw.z), bf_hi(yw.z), bf_lo(yw.w), bf_hi(yw.w)};
                    const f32x4 a0 = acc[ai][bj][m][0] + b0, a1 = acc[ai][bj][m][1] + b1; f32x4 o0, o1;
#pragma unroll
                    for (int e = 0; e < 4; ++e) { o0[e] = y0[e] * __builtin_amdgcn_rcpf(1.0f + __builtin_amdgcn_exp2f(-1.4426950408889634f * a0[e]));
                                                  o1[e] = y1[e] * __builtin_amdgcn_rcpf(1.0f + __builtin_amdgcn_exp2f(-1.4426950408889634f * a1[e])); }
                    part += sum4sq(o0) + sum4sq(o1);
                    u32x4 w; w.x = cvt_pk_bf16(o0[0], o0[1]); w.y = cvt_pk_bf16(o0[2], o0[3]); w.z = cvt_pk_bf16(o1[0], o1[1]); w.w = cvt_pk_bf16(o1[2], o1[3]);
                    *(u32x4*)(MIX + (size_t)row * DM + c0) = w; }
                part += __shfl_xor(part, 16); part += __shfl_xor(part, 32);
                if (fq == 0) ss_add(ss, row, part);
                asm volatile("" ::: "memory"); }
    }
};
struct EpiResid {
    static constexpr bool PERM = false, AFTER_DRAIN = false;
    float* X; bf16_t* XB; const unsigned long long* ss_scale; float inv_n_scale; unsigned long long* ss_out;
    __device__ __forceinline__ void operator()(const f32x4 (&acc)[2][2][4][2], const Unit& u, int wr, int wc, int fr, int fq) const {
        const int row0 = u.pm * BM + wr * 64 + fr;
#pragma unroll
        for (int ai = 0; ai < 2; ++ai)
#pragma unroll
            for (int m = 0; m < 4; ++m) { const int row = row0 + ai * HALF + m * 16; const float rs = ss_scale ? rs_from_ss(ss_scale, row, inv_n_scale) : 1.0f; float part = 0.f;
#pragma unroll
                for (int bj = 0; bj < 2; ++bj)
#pragma unroll
                    for (int n = 0; n < 2; ++n) { const size_t off = (size_t)row * DM + u.pn * BM + bj * HALF + wc * 32 + n * 16 + 4 * fq;
                        const f32x4 xn = *(const f32x4*)(X + off) + acc[ai][bj][m][n] * rs;
                        *(f32x4*)(X + off) = xn; part += sum4sq(xn);
                        u32x2 w; w.x = cvt_pk_bf16(xn[0], xn[1]); w.y = cvt_pk_bf16(xn[2], xn[3]); *(u32x2*)(XB + off) = w; }
                part += __shfl_xor(part, 16); part += __shfl_xor(part, 32);
                if (fq == 0) ss_add(ss_out, row, part);
                asm volatile("" ::: "memory"); }
    }
};
struct EpiGateUp {
    static constexpr bool PERM = true, AFTER_DRAIN = false;
    bf16_t* H; int ldh; const unsigned long long* ss;
    __device__ __forceinline__ void operator()(const f32x4 (&acc)[2][2][4][2], const Unit& u, int wr, int wc, int fr, int fq) const {
        const int row0 = u.pm * BM + wr * 64 + fr;
#pragma unroll
        for (int ai = 0; ai < 2; ++ai)
#pragma unroll
            for (int m = 0; m < 4; ++m) { const int row = row0 + ai * HALF + m * 16; const float rs = ss ? rs_from_ss(ss, row, 1.0f / DM) : 1.0f;
                f32x4 h[2];
#pragma unroll
                for (int n = 0; n < 2; ++n) { const f32x4 g = acc[ai][0][m][n] * rs, up = acc[ai][1][m][n] * rs;
#pragma unroll
                    for (int e = 0; e < 4; ++e) h[n][e] = g[e] * __builtin_amdgcn_rcpf(1.0f + __builtin_amdgcn_exp2f(-1.4426950408889634f * g[e])) * up[e]; }
                u32x4 w; w.x = cvt_pk_bf16(h[0][0], h[0][1]); w.y = cvt_pk_bf16(h[0][2], h[0][3]); w.z = cvt_pk_bf16(h[1][0], h[1][1]); w.w = cvt_pk_bf16(h[1][2], h[1][3]);
                *(u32x4*)(H + (size_t)row * ldh + u.pn * HALF + wc * 32 + 8 * fq) = w;
                asm volatile("" ::: "memory"); }
    }
};
struct EpiStoreBf16 {
    static constexpr bool PERM = true, AFTER_DRAIN = false;
    bf16_t* O; int ldc;
    __device__ __forceinline__ void operator()(const f32x4 (&acc)[2][2][4][2], const Unit& u, int wr, int wc, int fr, int fq) const {
        const int row0 = u.pm * BM + wr * 64 + fr;
#pragma unroll
        for (int ai = 0; ai < 2; ++ai)
#pragma unroll
            for (int m = 0; m < 4; ++m) { bf16_t* rowp = O + (size_t)(row0 + ai * HALF + m * 16) * ldc + u.pn * BM + wc * 32 + 8 * fq;
#pragma unroll
                for (int bj = 0; bj < 2; ++bj) { const f32x4 v0 = acc[ai][bj][m][0], v1 = acc[ai][bj][m][1];
                    u32x4 w; w.x = cvt_pk_bf16(v0[0], v0[1]); w.y = cvt_pk_bf16(v0[2], v0[3]); w.z = cvt_pk_bf16(v1[0], v1[1]); w.w = cvt_pk_bf16(v1[2], v1[3]);
                    *(u32x4*)(rowp + bj * HALF) = w; } }
    }
};

template <class Epi, class Sched, bool ALIGN_EPI = false, bool SP2 = false>
__device__ __forceinline__ void gemm_phase(PG8_LAS unsigned char* lds, const Gemm g, const Sched& S, const Epi& E) {
    int tid_ = threadIdx.x; asm volatile("" : "+v"(tid_));
    const int tid = tid_, wid = __builtin_amdgcn_readfirstlane(tid >> 6), lane = tid & 63, wr = wid >> 2, wc = wid & 3, fr = lane & 15, fq = lane >> 4;
    const int K = g.K, nt = K / BK;
    unsigned voffA[2], voffB[2];
#pragma unroll
    for (int i = 0; i < 2; ++i) { int R, C; stage_rc(tid * 16 + i * 8192, R, C); const int Rb = Epi::PERM ? ((R & ~31) + perm32(R & 31)) : R;
        voffA[i] = (unsigned)(R * K + C) * 2u; voffB[i] = (unsigned)(Rb * K + C) * 2u; }
    const size_t kstep = (size_t)(BK * 2);
    const size_t hstep = (size_t)HALF * K * 2;
    const size_t tstep = 2 * hstep;
    const unsigned ldsw = (unsigned)wid * 1024u;
    const int aoff = lds_byte(wr * 64 + fr, fq * 8), boff = lds_byte(wc * 32 + fr, fq * 8);
#define PG8_SA(b, h) (((b) * 2 + (h)) * HTB)
#define PG8_SB(b, h) ((4 + (b) * 2 + (h)) * HTB)
#define PG8_STAGE(bufoff, gbase, voff) do { _Pragma("unroll") for (int _i = 0; _i < 2; ++_i) \
        __builtin_amdgcn_global_load_lds((const unsigned*)((const char*)(gbase) + (voff)[_i]), (PG8_LAS unsigned*)(lds + (bufoff) + ldsw + _i * 8192), 16, 0, 0); } while (0)
#define PG8_LDA(dst, b, h) do { _Pragma("unroll") for (int m = 0; m < 4; ++m) _Pragma("unroll") for (int k = 0; k < 2; ++k) dst[m][k] = *(const PG8_LAS bf16x8*)(lds + PG8_SA(b, h) + aoff + m * 2048 + k * 1024); } while (0)
#define PG8_LDB(dst, b, h) do { _Pragma("unroll") for (int n = 0; n < 2; ++n) _Pragma("unroll") for (int k = 0; k < 2; ++k) dst[n][k] = *(const PG8_LAS bf16x8*)(lds + PG8_SB(b, h) + boff + n * 2048 + k * 1024); } while (0)
#define PG8_MMA(ai, bj, At, Bt) do { __builtin_amdgcn_s_setprio(1); _Pragma("unroll") for (int m = 0; m < 4; ++m) _Pragma("unroll") for (int n = 0; n < 2; ++n) _Pragma("unroll") for (int k = 0; k < 2; ++k) \
        acc[ai][bj][m][n] = __builtin_amdgcn_mfma_f32_16x16x32_bf16(Bt[n][k], At[m][k], acc[ai][bj][m][n], 0, 0, 0); __builtin_amdgcn_s_setprio(0); } while (0)
#define PG8_WAIT_V(n) asm volatile("s_waitcnt vmcnt(" #n ")" ::: "memory")
#define PG8_WAIT_L(n) asm volatile("s_waitcnt lgkmcnt(" #n ")" ::: "memory")
#define PG8_BAR __builtin_amdgcn_s_barrier()
#define PG8_SCHED __builtin_amdgcn_sched_barrier(0)
    Unit cur, nxt; int ui = 0;
    if (!S.next(0, cur)) return;
    f32x4 acc[2][2][4][2];
#pragma unroll
    for (int a = 0; a < 2; ++a)
#pragma unroll
        for (int b = 0; b < 2; ++b)
#pragma unroll
            for (int m = 0; m < 4; ++m)
#pragma unroll
                for (int n = 0; n < 2; ++n) acc[a][b][m][n] = (f32x4){0.f, 0.f, 0.f, 0.f};
    bf16x8 At[4][2], B0[2][2], B1[2][2];
    const char* cA = (const char*)g.A + (size_t)cur.pm * tstep; const char* cB = (const char*)g.Bt + (size_t)cur.e * g.be + (size_t)cur.pn * tstep;
    S.a_ready(cur);
    if constexpr (SP2) {
        PG8_STAGE(PG8_SB(0, 0), cB, voffB); PG8_STAGE(PG8_SB(0, 1), cB + hstep, voffB); PG8_STAGE(PG8_SA(0, 0), cA, voffA); PG8_STAGE(PG8_SA(0, 1), cA + hstep, voffA);
        if (wr == 1) PG8_BAR;
        PG8_WAIT_V(2); PG8_BAR;
        PG8_STAGE(PG8_SB(1, 0), cB + kstep, voffB); PG8_STAGE(PG8_SA(1, 0), cA + kstep, voffA); PG8_STAGE(PG8_SB(1, 1), cB + hstep + kstep, voffB);
        PG8_WAIT_V(6); PG8_BAR;
    } else {
        PG8_STAGE(PG8_SB(0, 0), cB, voffB); PG8_STAGE(PG8_SA(0, 0), cA, voffA); PG8_STAGE(PG8_SB(0, 1), cB + hstep, voffB); PG8_STAGE(PG8_SA(0, 1), cA + hstep, voffA);
        if (wr == 1) PG8_BAR;
        PG8_WAIT_V(4); PG8_BAR;
        PG8_STAGE(PG8_SB(1, 0), cB + kstep, voffB); PG8_STAGE(PG8_SA(1, 0), cA + kstep, voffA); PG8_STAGE(PG8_SB(1, 1), cB + hstep + kstep, voffB);
        PG8_WAIT_V(6); PG8_BAR;
    }
    for (;;) {
        const bool has_next = S.next(ui + 1, nxt);
        const char* nA = has_next ? (const char*)g.A + (size_t)nxt.pm * tstep : cA; const char* nB = has_next ? (const char*)g.Bt + (size_t)nxt.e * g.be + (size_t)nxt.pn * tstep : cB;
        for (int t = 0; t < nt; t += 2) {
            const bool last = (t == nt - 2);
            const char* a1 = cA + (size_t)(t + 1) * kstep;
            const char* a2 = last ? nA : cA + (size_t)(t + 2) * kstep; const char* b2 = last ? nB : cB + (size_t)(t + 2) * kstep;
            const char* a3 = a2 + kstep; const char* b3 = b2 + kstep;
            if (last && has_next) S.a_ready(nxt);
            if constexpr (SP2) {
            PG8_LDB(B0, 0, 0); PG8_LDB(B1, 0, 1); PG8_SCHED; PG8_LDA(At, 0, 0); PG8_STAGE(PG8_SA(1, 1), a1 + hstep, voffA);
            PG8_WAIT_V(8); PG8_WAIT_L(0); PG8_BAR; PG8_MMA(0, 0, At, B0); PG8_MMA(0, 1, At, B1); PG8_BAR; PG8_SCHED;
            PG8_LDA(At, 0, 1); PG8_STAGE(PG8_SB(0, 0), b2, voffB); PG8_STAGE(PG8_SB(0, 1), b2 + hstep, voffB); PG8_STAGE(PG8_SA(0, 0), a2, voffA);
            PG8_WAIT_V(8); PG8_WAIT_L(0); PG8_BAR; PG8_MMA(1, 0, At, B0); PG8_MMA(1, 1, At, B1); PG8_BAR; PG8_SCHED;
            PG8_LDB(B0, 1, 0); PG8_LDB(B1, 1, 1); PG8_SCHED; PG8_LDA(At, 1, 0); PG8_STAGE(PG8_SA(0, 1), a2 + hstep, voffA);
            PG8_WAIT_V(8); PG8_WAIT_L(0); PG8_BAR; PG8_MMA(0, 0, At, B0); PG8_MMA(0, 1, At, B1); PG8_BAR; PG8_SCHED;
            PG8_LDA(At, 1, 1); PG8_STAGE(PG8_SB(1, 0), b3, voffB); PG8_STAGE(PG8_SB(1, 1), b3 + hstep, voffB); PG8_STAGE(PG8_SA(1, 0), a3, voffA);
            PG8_WAIT_V(8); PG8_WAIT_L(0); PG8_BAR; PG8_MMA(1, 0, At, B0); PG8_MMA(1, 1, At, B1); PG8_BAR; PG8_SCHED;
            } else {
            PG8_LDB(B0, 0, 0); PG8_SCHED; PG8_LDA(At, 0, 0); PG8_STAGE(PG8_SA(1, 1), a1 + hstep, voffA);
            PG8_WAIT_L(8); PG8_BAR; PG8_WAIT_L(0); PG8_MMA(0, 0, At, B0); PG8_BAR; PG8_SCHED;
            PG8_LDB(B1, 0, 1); PG8_STAGE(PG8_SB(0, 0), b2, voffB);
            PG8_BAR; PG8_WAIT_L(0); PG8_MMA(0, 1, At, B1); PG8_BAR;
            PG8_LDA(At, 0, 1); PG8_STAGE(PG8_SA(0, 0), a2, voffA);
            PG8_BAR; PG8_WAIT_L(0); PG8_MMA(1, 0, At, B0); PG8_BAR; PG8_SCHED;
            PG8_STAGE(PG8_SB(0, 1), b2 + hstep, voffB);
            PG8_WAIT_V(6); PG8_BAR; PG8_MMA(1, 1, At, B1); PG8_BAR;
            PG8_LDB(B0, 1, 0); PG8_SCHED; PG8_LDA(At, 1, 0); PG8_STAGE(PG8_SA(0, 1), a2 + hstep, voffA);
            PG8_WAIT_L(8); PG8_BAR; PG8_WAIT_L(0); PG8_MMA(0, 0, At, B0); PG8_BAR; PG8_SCHED;
            PG8_LDB(B1, 1, 1); PG8_STAGE(PG8_SB(1, 0), b3, voffB);
            PG8_BAR; PG8_WAIT_L(0); PG8_MMA(0, 1, At, B1); PG8_BAR;
            PG8_LDA(At, 1, 1); PG8_STAGE(PG8_SA(1, 0), a3, voffA);
            PG8_BAR; PG8_WAIT_L(0); PG8_MMA(1, 0, At, B0); PG8_BAR; PG8_SCHED;
            PG8_STAGE(PG8_SB(1, 1), b3 + hstep, voffB);
            PG8_WAIT_V(6); PG8_BAR; PG8_MMA(1, 1, At, B1); PG8_BAR;
            }
        }
        if constexpr (ALIGN_EPI) { if (wr == 0) PG8_BAR; }
        if constexpr (!Epi::AFTER_DRAIN) { E(acc, cur, wr, wc, fr, fq); S.done(cur); }
        if (!has_next) break;
#pragma unroll
        for (int a = 0; a < 2; ++a)
#pragma unroll
            for (int b = 0; b < 2; ++b)
#pragma unroll
                for (int m = 0; m < 4; ++m)
#pragma unroll
                    for (int n = 0; n < 2; ++n) acc[a][b][m][n] = (f32x4){0.f, 0.f, 0.f, 0.f};
        cur = nxt; cA = nA; cB = nB; ++ui;
        if constexpr (ALIGN_EPI) { if (wr == 1) PG8_BAR; }
    }
    PG8_WAIT_V(0);
    if constexpr (!ALIGN_EPI) { if (wr == 0) PG8_BAR; }
    PG8_BAR;
    if constexpr (Epi::AFTER_DRAIN) { E.fused(acc, cur, wr, wc, fr, fq, lds, wid, lane); S.done(cur); }
#undef PG8_SA
#undef PG8_SB
#undef PG8_STAGE
#undef PG8_LDA
#undef PG8_LDB
#undef PG8_MMA
#undef PG8_WAIT_V
#undef PG8_WAIT_L
#undef PG8_BAR
#undef PG8_SCHED
}
}


namespace att {
using bf16 = unsigned short;
using bf16x8 = __attribute__((ext_vector_type(8))) short;
using s16x4  = __attribute__((ext_vector_type(4))) short;
using f32x16 = __attribute__((ext_vector_type(16))) float;
using u32x4  = __attribute__((ext_vector_type(4))) unsigned;
constexpr int NW = 8, QBLK = 32, KVBLK = 64, LDQ = 512;
constexpr int SHM_V = KVBLK * 128 * 2, SHM_K = KVBLK * 64 * 2, SHM_ATTN = 2 * SHM_V + 2 * SHM_K + NW * 64 * 4;
constexpr float THR2 = 8.f;
#define ATT_KSWZ(row, colB) ((row) * 128 + ((colB) ^ ((((row) >> 1) & 7) << 4)))
#define ATT_SBAR() __builtin_amdgcn_sched_barrier(0)
__device__ __forceinline__ int crow(int r, int hi) { return (r & 3) + 8 * (r >> 2) + 4 * hi; }
__device__ __forceinline__ unsigned cvtpk(float lo, float hi) { unsigned r; asm volatile("v_cvt_pk_bf16_f32 %0, %1, %2" : "=v"(r) : "v"(lo), "v"(hi)); return r; }

__device__ __forceinline__ void partialSM(f32x16& p0, f32x16& p1, float dq, float nsl2, float& m_reg, float& alpha) {
  asm volatile("" : "+v"(dq));
#pragma unroll
  for (int r = 0; r < 16; ++r) { const float c = (float)((r & 3) + 8 * (r >> 2));
    p0[r] = fmaf(nsl2, fabsf(dq - c), p0[r]); p1[r] = fmaf(nsl2, fabsf(dq - (c + 32.f)), p1[r]); }
  float pmax = p0[0];
#pragma unroll
  for (int r = 1; r < 16; ++r) pmax = fmaxf(pmax, p0[r]);
#pragma unroll
  for (int r = 0; r < 16; ++r) pmax = fmaxf(pmax, p1[r]);
  { auto rr = __builtin_amdgcn_permlane32_swap(__float_as_uint(pmax), __float_as_uint(pmax), false, false);
    pmax = fmaxf(__uint_as_float(rr[0]), __uint_as_float(rr[1])); }
  float mn;
  if (__builtin_expect(__all(pmax - m_reg <= THR2), 1)) { mn = m_reg; alpha = 1.f; }
  else { mn = fmaxf(m_reg, pmax); alpha = __builtin_amdgcn_exp2f(m_reg - mn); m_reg = mn; }
#pragma unroll
  for (int r = 0; r < 16; ++r) { p0[r] = p0[r] - mn; p1[r] = p1[r] - mn; }
#pragma unroll
  for (int r = 0; r < 16; ++r) p0[r] = __builtin_amdgcn_exp2f(p0[r]);
}
__device__ __forceinline__ void finishSM(f32x16& p0, f32x16& p1, float alpha, float& l_reg, bf16x8& pa0, bf16x8& pa1, bf16x8& pa2, bf16x8& pa3) {
#pragma unroll
  for (int r = 0; r < 16; ++r) p1[r] = __builtin_amdgcn_exp2f(p1[r]);
  float ps = 0;
#pragma unroll
  for (int r = 0; r < 16; ++r) ps += p0[r];
#pragma unroll
  for (int r = 0; r < 16; ++r) ps += p1[r];
  { auto rr = __builtin_amdgcn_permlane32_swap(__float_as_uint(ps), __float_as_uint(ps), false, false);
    ps = __uint_as_float(rr[0]) + __uint_as_float(rr[1]); }
  l_reg = l_reg * alpha + ps;
#define ATT_PK4(P, BASE, OUT) do { unsigned a0 = cvtpk(P[BASE + 0], P[BASE + 1]), a1 = cvtpk(P[BASE + 2], P[BASE + 3]);   \
    unsigned b0 = cvtpk(P[BASE + 4], P[BASE + 5]), b1 = cvtpk(P[BASE + 6], P[BASE + 7]);                              \
    auto r0 = __builtin_amdgcn_permlane32_swap(a0, b0, false, false); auto r1 = __builtin_amdgcn_permlane32_swap(a1, b1, false, false); \
    u32x4 w = {r0[0], r1[0], r0[1], r1[1]}; OUT = *reinterpret_cast<bf16x8*>(&w); } while (0)
  ATT_PK4(p0, 0, pa0); ATT_PK4(p0, 8, pa1); ATT_PK4(p1, 0, pa2); ATT_PK4(p1, 8, pa3);
#undef ATT_PK4
}
typedef __attribute__((address_space(3))) char lchar;
typedef __attribute__((address_space(3))) float lfloat;
__device__ __forceinline__ void qkt(f32x16& p0, f32x16& p1, const lchar* Ks, const bf16x8* qr, int r32, int hi) {
  p0 = f32x16{}; p1 = f32x16{};
#pragma unroll
  for (int d0 = 0; d0 < 4; ++d0) { const int cb = (d0 * 16 + hi * 8) * 2;
    const bf16x8 b0 = *(const __attribute__((address_space(3))) bf16x8*)(Ks + ATT_KSWZ(r32, cb));
    const bf16x8 b1 = *(const __attribute__((address_space(3))) bf16x8*)(Ks + ATT_KSWZ(32 + r32, cb));
    p0 = __builtin_amdgcn_mfma_f32_32x32x16_bf16(b0, qr[d0], p0, 0, 0, 0);
    p1 = __builtin_amdgcn_mfma_f32_32x32x16_bf16(b1, qr[d0], p1, 0, 0, 0); }
}
__device__ __forceinline__ int v_st(int k, int c) { const int kk = (k & ~0xC) | ((k & 4) << 1) | ((k & 8) >> 1); return ((kk >> 3) * 4 + (c >> 5)) * 512 + ((kk & 7) * 32 + (c & 31)) * 2; }
__device__ __forceinline__ int v_rd_base(int lane) { return ((lane & 3) << 3) | (((lane >> 2) & 3) << 6) | (((lane >> 4) & 1) << 5) | (((lane >> 5) & 1) << 8); }
constexpr int v_rd_off(int d0, int ks, int half) { return d0 * 512 + ks * 4096 + half * 2048; }
template <int OFF> __device__ __forceinline__ s16x4 tr_read(int vb) {
  s16x4 r; asm volatile("ds_read_b64_tr_b16 %0, %1 offset:%2" : "=&v"(r) : "v"(vb), "i"(OFF) : "memory"); return r;
}
template <int D0> __device__ __forceinline__ void pv_one(f32x16& od, int vb, bf16x8 pa0, bf16x8 pa1, bf16x8 pa2, bf16x8 pa3) {
  const s16x4 l0 = tr_read<v_rd_off(D0, 0, 0)>(vb), h0 = tr_read<v_rd_off(D0, 0, 1)>(vb), l1 = tr_read<v_rd_off(D0, 1, 0)>(vb), h1 = tr_read<v_rd_off(D0, 1, 1)>(vb);
  const s16x4 l2 = tr_read<v_rd_off(D0, 2, 0)>(vb), h2 = tr_read<v_rd_off(D0, 2, 1)>(vb), l3 = tr_read<v_rd_off(D0, 3, 0)>(vb), h3 = tr_read<v_rd_off(D0, 3, 1)>(vb);
  asm volatile("s_waitcnt lgkmcnt(0)" ::: "memory"); ATT_SBAR();
#define ATT_PK(L, H) (bf16x8){L[0], L[1], L[2], L[3], H[0], H[1], H[2], H[3]}
  od = __builtin_amdgcn_mfma_f32_32x32x16_bf16(pa0, ATT_PK(l0, h0), od, 0, 0, 0);
  od = __builtin_amdgcn_mfma_f32_32x32x16_bf16(pa1, ATT_PK(l1, h1), od, 0, 0, 0);
  od = __builtin_amdgcn_mfma_f32_32x32x16_bf16(pa2, ATT_PK(l2, h2), od, 0, 0, 0);
  od = __builtin_amdgcn_mfma_f32_32x32x16_bf16(pa3, ATT_PK(l3, h3), od, 0, 0, 0);
#undef ATT_PK
}
__device__ __forceinline__ void pv_d0(f32x16* o, int vb, bf16x8 pa0, bf16x8 pa1, bf16x8 pa2, bf16x8 pa3) {
  pv_one<0>(o[0], vb, pa0, pa1, pa2, pa3); pv_one<1>(o[1], vb, pa0, pa1, pa2, pa3); pv_one<2>(o[2], vb, pa0, pa1, pa2, pa3); pv_one<3>(o[3], vb, pa0, pa1, pa2, pa3);
}

__device__ __forceinline__ void attn_pass(const bf16* __restrict__ Qw, const bf16* __restrict__ Kh, const bf16* __restrict__ Vh, int qpos0, float nsl2, lchar* lds, f32x16 (&o)[4], float& l_out) {
  int tid_ = threadIdx.x; asm volatile("" : "+v"(tid_));
  const int tid = tid_, wid = tid >> 6, lane = tid & 63, r32 = lane & 31, hi = lane >> 5;
  lchar* V_lds = lds; lchar* K_lds = lds + 2 * SHM_V;
  lfloat* ws = (lfloat*)(lds + 2 * SHM_V + 2 * SHM_K) + wid * 64; lfloat* al_l = ws + 32;
  float m_reg = -1e30f, l_reg = 0;
#pragma unroll
  for (int d = 0; d < 4; ++d) o[d] = f32x16{};
  bf16x8 qr[4];
#pragma unroll
  for (int d0 = 0; d0 < 4; ++d0) qr[d0] = *reinterpret_cast<const bf16x8*>(Qw + (long)r32 * LDQ + d0 * 16 + hi * 8);
  const int sr = tid >> 4, sc = (tid & 15) * 8, vst0 = v_st(sr, sc), vst1 = v_st(32 + sr, sc);
  const int kr = tid >> 3, kcB = (tid & 7) * 16, kst = ATT_KSWZ(kr, kcB);
  const int vb0 = (int)(unsigned)(uintptr_t)V_lds + v_rd_base(lane);
  const float dqbase = (float)(qpos0 + wid * QBLK + r32 - 4 * hi);
  bf16x8 vs0, vs1, ks0;
#define ATT_SLOAD(k0) do { vs0 = *reinterpret_cast<const bf16x8*>(&Vh[(long)((k0) + sr) * LDQ + sc]); vs1 = *reinterpret_cast<const bf16x8*>(&Vh[(long)((k0) + 32 + sr) * LDQ + sc]); \
    ks0 = *reinterpret_cast<const bf16x8*>(&Kh[(long)((k0) + kr) * LDQ + (kcB >> 1)]); } while (0)
#define ATT_SWRITE(b) do { *(__attribute__((address_space(3))) bf16x8*)(V_lds + (b) * SHM_V + vst0) = vs0; *(__attribute__((address_space(3))) bf16x8*)(V_lds + (b) * SHM_V + vst1) = vs1; \
    *(__attribute__((address_space(3))) bf16x8*)(K_lds + (b) * SHM_K + kst) = ks0; } while (0)
  constexpr int NT = SEQ / KVBLK;
  ATT_SLOAD(0); ATT_SWRITE(0); ATT_SLOAD(KVBLK); ATT_SWRITE(1);
  __syncthreads();
#pragma unroll 1
  for (int j = 0; j < NT; ++j) {
    const int b = j & 1;
    if (j + 2 < NT) ATT_SLOAD((j + 2) * KVBLK);
    f32x16 p0, p1; float alpha; bf16x8 pa0, pa1, pa2, pa3;
    qkt(p0, p1, K_lds + b * SHM_K, qr, r32, hi);
    partialSM(p0, p1, dqbase - (float)(j * KVBLK), nsl2, m_reg, alpha);
    finishSM(p0, p1, alpha, l_reg, pa0, pa1, pa2, pa3);
    if (__any(alpha < 1.f)) { if (hi == 0) al_l[r32] = alpha; asm volatile("s_waitcnt lgkmcnt(0)" ::: "memory");
#pragma unroll
      for (int d = 0; d < 4; ++d)
#pragma unroll
        for (int r = 0; r < 16; ++r) o[d][r] *= al_l[crow(r, hi)]; }
    ATT_SBAR();
    pv_d0(o, vb0 + b * SHM_V, pa0, pa1, pa2, pa3);
    __syncthreads();
    if (j + 2 < NT) ATT_SWRITE(b);
  }
  l_out = l_reg;
  __syncthreads();
#undef ATT_SLOAD
#undef ATT_SWRITE
}
}


#define GAS __attribute__((address_space(1)))
#define LAS __attribute__((address_space(3)))
typedef unsigned short bf16;
typedef unsigned v4u __attribute__((ext_vector_type(4)));
typedef float f32x4 __attribute__((ext_vector_type(4)));
typedef short bf16x8 __attribute__((ext_vector_type(8)));
typedef GAS unsigned gu32;
typedef GAS unsigned long long gu64;
#define RLX_AGENT __ATOMIC_RELAXED, __HIP_MEMORY_SCOPE_AGENT
#define LDS_WAIT() asm volatile("s_waitcnt lgkmcnt(0)" ::: "memory")
#define VM_WAIT() asm volatile("s_waitcnt vmcnt(0)" ::: "memory")
__device__ __forceinline__ unsigned long long rt() { return __builtin_amdgcn_s_memrealtime(); }
__device__ __forceinline__ unsigned f2bf(float f) { unsigned u = __builtin_bit_cast(unsigned, f); return (u + 0x7fffu + ((u >> 16) & 1u)) >> 16; }
__device__ __forceinline__ unsigned pk2(float lo, float hi) { return f2bf(lo) | (f2bf(hi) << 16); }

#define XB_TMO      128
#define XB_XCNT(j)  (256  + 64 * (j))
#define XB_XSUB(j)  (1280 + 64 * (j))
#define XB_XGEN(j)  (2304 + 64 * (j))
#define XB_TOP      3328
#define XB_TOPGEN   3392
#define XCD_BAR_WORDS 3456
#define XB_SPIN_CAP (1u << 18)

__device__ __forceinline__ unsigned xb_ld(unsigned* p)              { return __hip_atomic_load(p, __ATOMIC_RELAXED, __HIP_MEMORY_SCOPE_AGENT); }
__device__ __forceinline__ unsigned xb_add(unsigned* p, unsigned v) { return __hip_atomic_fetch_add(p, v, __ATOMIC_RELAXED, __HIP_MEMORY_SCOPE_AGENT); }
__device__ __forceinline__ unsigned xb_xcc_id() { return (unsigned)__builtin_amdgcn_s_getreg((3 << 11) | 20) & 0xFu; }
#define XB_SPIN(cond, bar) do { unsigned _sp = 0; while (cond) { __builtin_amdgcn_s_sleep(1); \
    if ((++_sp & 255u) == 0u) { if (xb_ld(&(bar)[XB_TMO])) break; if (_sp > XB_SPIN_CAP) { atomicAdd(&(bar)[XB_TMO], 1u); break; } } } } while (0)

struct XcdBarrier {
    unsigned* bar; unsigned x;
    volatile LAS unsigned* st;
};

__device__ __forceinline__ XcdBarrier xcd_barrier_post(unsigned* bar, volatile LAS unsigned* st) {
    XcdBarrier b; b.bar = bar; b.x = xb_xcc_id(); b.st = st;
    if (threadIdx.x == 0) (void)xb_add(&bar[XB_XCNT(b.x)], 1u);
    return b;
}
__device__ __forceinline__ void xcd_barrier_complete(unsigned* bar, unsigned x, unsigned& nloc, unsigned& nx) {
    const unsigned G = gridDim.x * gridDim.y * gridDim.z;
    unsigned sum, cnt, mine, sp = 0u;
    for (;;) {
        sum = 0u; cnt = 0u; mine = 0u;
#pragma unroll
        for (unsigned j = 0; j < 16; ++j) { const unsigned c = xb_ld(&bar[XB_XCNT(j)]); sum += c; cnt += (c > 0u) ? 1u : 0u; mine = (j == x) ? c : mine; }
        if (sum == G) break;
        __builtin_amdgcn_s_sleep(1);
        if ((++sp & 255u) == 0u) { if (xb_ld(&bar[XB_TMO])) break; if (sp > XB_SPIN_CAP) { atomicAdd(&bar[XB_TMO], 1u); break; } }
    }
    nloc = mine > 0u ? mine : 1u; nx = cnt > 0u ? cnt : 1u;
}

__device__ __forceinline__ void xcd_barrier(const XcdBarrier& b) {
    asm volatile("s_waitcnt vmcnt(0)" ::: "memory");
    __syncthreads();
    if (threadIdx.x == 0) {
        unsigned* bar = b.bar;
        __builtin_amdgcn_s_waitcnt(0);
        unsigned nloc = b.st[0], nx = b.st[1];
        if (nloc == 0u) { xcd_barrier_complete(bar, b.x, nloc, nx); b.st[0] = nloc; b.st[1] = nx; }
        const unsigned old = xb_add(&bar[XB_XSUB(b.x)], 1u);
        const unsigned gen = old / nloc;
        if (old + 1u == (gen + 1u) * nloc) {
            __builtin_amdgcn_fence(__ATOMIC_RELEASE, "agent");
            asm volatile("s_waitcnt vmcnt(0)" ::: "memory");
            const unsigned og = xb_add(&bar[XB_TOP], 1u);
            const unsigned tg = og / nx;
            if (og + 1u == (tg + 1u) * nx) xb_add(&bar[XB_TOPGEN], 1u);
            else XB_SPIN(xb_ld(&bar[XB_TOPGEN]) == tg, bar);
            __builtin_amdgcn_fence(__ATOMIC_ACQUIRE, "agent");
            xb_add(&bar[XB_XGEN(b.x)], 1u);
            asm volatile("s_waitcnt vmcnt(0)" ::: "memory");
        } else {
            XB_SPIN(xb_ld(&bar[XB_XGEN(b.x)]) == gen, bar);
            __builtin_amdgcn_fence(__ATOMIC_ACQUIRE, "agent");
            asm volatile("s_waitcnt vmcnt(0)" ::: "memory");
        }
    }
    __syncthreads();
}

constexpr size_t MiB = 1u << 20;
constexpr size_t WS_CTL = 0;
constexpr size_t WS_SS = 1 * MiB;
constexpr size_t ZERO_BYTES = 4 * MiB;
constexpr size_t WS_ROUTE = 4 * MiB;
constexpr size_t WS_WR = 5 * MiB;
constexpr size_t WS_WIN = 6 * MiB;
constexpr size_t WS_WGLU = WS_WIN + 16 * MiB;
constexpr size_t WS_WOUT = WS_WGLU + 2 * MiB;
constexpr size_t WS_DGU = WS_WOUT + 8 * MiB;
constexpr size_t WS_DDN = WS_DGU + 22 * MiB;
constexpr size_t WS_MGU = WS_DDN + 11 * MiB;
constexpr size_t WS_MDN = WS_MGU + 224 * MiB;
constexpr size_t WS_XB = WS_MDN + 112 * MiB;
constexpr size_t WS_B = WS_XB + 64 * MiB;
static_assert(WS_B == 465 * MiB, "map");
constexpr size_t WS_UG = WS_B, WS_Q = WS_B + 32 * MiB, WS_K = WS_B + 64 * MiB, WS_V = WS_B + 96 * MiB, WS_Y = WS_B + 128 * MiB, WS_MIX = WS_B + 160 * MiB;
constexpr size_t WS_ATMP = WS_B + 224 * MiB;
constexpr size_t WS_YTMP = WS_B + 288 * MiB;
constexpr size_t WS_HD = WS_B;
constexpr size_t WS_XG = WS_B;
constexpr int MOE_TILES_MAX = (2 * M) / 256 + NEXP;
constexpr int MOE_ROWS = MOE_TILES_MAX * 256;
constexpr size_t WS_HM = WS_XG + 132 * MiB;
constexpr int HM_TILES = 168;
constexpr size_t WS_END = WS_HM + (size_t)HM_TILES * 256 * DFE * 2;
static_assert(WS_END <= 896 * MiB && WS_YTMP + 128 * MiB <= 896 * MiB && 2 * HM_TILES >= MOE_TILES_MAX, "d_ws budget");
constexpr int CW_BAR = 4096;
constexpr int CW_ROUTE = 16384;
__host__ __device__ constexpr int SS_MIXN(int L) { return L; }
__host__ __device__ constexpr int SS_GLU(int L) { return 4 + L; }
__host__ __device__ constexpr int SS_FFN(int L) { return 8 + L; }

constexpr int RING_OFF = 0, RING_BYTES = 131072;
constexpr int LDSCTL_OFF = RING_BYTES, MISC_OFF = LDSCTL_OFF + 320;
constexpr int LDS_BYTES = 147456;
constexpr int NWAVES = 8;

struct Frame {
    LAS unsigned char* lds;
    volatile LAS unsigned* MISC;
    gu32* ctl;
    int tid, lane, wave;
    int vcu, G;
    float* out; unsigned char* ws;
};
struct Args { const float* in[30]; float* out; unsigned char* ws; int ph_lo, ph_hi; };
constexpr int ARGT_OFF = LDSCTL_OFF + 1024;
extern __shared__ __attribute__((aligned(16))) unsigned char g_lds[];
__device__ __forceinline__ unsigned long long argt(int k) {
    const LAS unsigned* t = (const LAS unsigned*)((LAS unsigned char*)g_lds + ARGT_OFF) + 2 * k;
    const unsigned lo = __builtin_amdgcn_readfirstlane(t[0]), hi = __builtin_amdgcn_readfirstlane(t[1]);
    return ((unsigned long long)hi << 32) | lo;
}
struct ArgView { __device__ __forceinline__ const float* operator[](int k) const { return (const float*)argt(k); } };
__device__ __forceinline__ Frame make_frame() {
    Frame F;
    F.lds = (LAS unsigned char*)g_lds;
    F.MISC = (volatile LAS unsigned*)(F.lds + MISC_OFF);
    { int t_ = threadIdx.x; asm volatile("" : "+v"(t_)); F.tid = t_; } F.lane = F.tid & 63; F.wave = __builtin_amdgcn_readfirstlane(F.tid >> 6);
    F.G = gridDim.x; { const int bx = blockIdx.x; F.vcu = (F.G % 8 == 0) ? (bx % 8) * (F.G / 8) + bx / 8 : bx; }
    F.out = (float*)argt(30); F.ws = (unsigned char*)argt(31); F.ctl = (gu32*)(F.ws + WS_CTL);
    return F;
}
__device__ __forceinline__ float wave_sum(float v) {
#pragma unroll
    for (int o = 1; o < 64; o <<= 1) v += __shfl_xor(v, o);
    return v;
}
__device__ __forceinline__ float lambda_init(int L) { return 0.8f - 0.6f * expf(-0.3f * (float)L); }

template <int RMAP, int GK, bool QS>
__device__ __forceinline__ void cvt_item(const float* W, int K, int N, bf16* WT, int ldk, const float* g0, const float* g1, float g1s, LAS float* scr, int item, int lane) {
    const int nblk = N / 32, kb = item / nblk, nb = item % nblk, k0 = 64 * kb, n0 = 32 * nb;
    float cs = 1.f; if (QS) { if (n0 >= 512 && n0 < 1024) cs = QSCALE; }
#pragma unroll 8
    for (int i = 0; i < 32; ++i) { const int kk = 2 * i + (lane >> 5), k = k0 + kk;
        float gv = cs; if (GK == 1) gv *= g0[k]; if (GK == 2) gv *= (k < 512) ? g0[k] : g1[(k - 512) & 127] * g1s;
        scr[kk * 33 + (lane & 31)] = W[(size_t)k * N + n0 + (lane & 31)] * gv; }
    LDS_WAIT(); asm volatile("" ::: "memory");
    const int c = lane & 7;
#pragma unroll
    for (int j = 0; j < 4; ++j) { const int n = (lane >> 3) + 8 * j; const LAS float* s = scr + (8 * c) * 33 + n;
        v4u o; o.x = pk2(s[0 * 33], s[1 * 33]); o.y = pk2(s[2 * 33], s[3 * 33]); o.z = pk2(s[4 * 33], s[5 * 33]); o.w = pk2(s[6 * 33], s[7 * 33]);
        const int nn = n0 + n; const int drow = (RMAP == 0) ? nn : ((nn >> 7) * 256 + (nn & 127) + (RMAP == 2 ? 128 : 0));
        *(GAS v4u*)(WT + (size_t)drow * ldk + k0 + 8 * c) = o; }
    LDS_WAIT(); asm volatile("" ::: "memory");
}
__device__ __forceinline__ void p0_prologue(Frame& F) {
    LAS float* scr = (LAS float*)(F.lds + RING_OFF + F.wave * 16384);
    const int gw = F.vcu * NWAVES + F.wave, NGW = F.G * NWAVES;
    const ArgView in; unsigned char* ws = F.ws;
    { constexpr int IPM = (DM / 64) * (IN_COLS / 32);
      for (int it = gw; it < DEPTH * IPM; it += NGW) { const int L = it / IPM, r = it % IPM;
        cvt_item<0, 1, true>(in[2] + (size_t)L * DM * IN_COLS, DM, IN_COLS, (bf16*)(ws + WS_WIN) + (size_t)L * IN_COLS * DM, DM, in[1] + L * DM, nullptr, 0.f, scr, r, F.lane); } }
    { constexpr int IPM = (SSM_W / 64) * (SSM_W / 32);
      for (int it = gw; it < DEPTH * IPM; it += NGW) { const int L = it / IPM, r = it % IPM;
        cvt_item<0, 0, false>(in[11] + (size_t)L * SSM_W * SSM_W, SSM_W, SSM_W, (bf16*)(ws + WS_WGLU) + (size_t)L * SSM_W * SSM_W, SSM_W, nullptr, nullptr, 0.f, scr, r, F.lane); } }
    { constexpr int IPM = (DM / 64) * (DM / 32);
      for (int it = gw; it < DEPTH * IPM; it += NGW) { const int L = it / IPM, r = it % IPM;
        cvt_item<0, 2, false>(in[19] + (size_t)L * DM * DM, DM, DM, (bf16*)(ws + WS_WOUT) + (size_t)L * DM * DM, DM, in[13] + L * SSM_W, in[18] + L * ATT_DV, 1.0f - lambda_init(L), scr, r, F.lane); } }
    { constexpr int IPM = (DM / 64) * (DFF / 32);
      for (int it = gw; it < 2 * IPM; it += NGW) { const int j = it / IPM, r = it % IPM; bf16* dst = (bf16*)(ws + WS_DGU) + (size_t)j * (2 * DFF_P) * DM;
        cvt_item<1, 1, false>(in[21] + (size_t)j * DM * DFF, DM, DFF, dst, DM, in[20] + (2 * j) * DM, nullptr, 0.f, scr, r, F.lane);
        cvt_item<2, 1, false>(in[22] + (size_t)j * DM * DFF, DM, DFF, dst, DM, in[20] + (2 * j) * DM, nullptr, 0.f, scr, r, F.lane); }
      for (int it = gw; it < 2 * 128; it += NGW) { const int j = it >> 7, rr = it & 127; const int drow = 21 * 256 + ((rr < 64) ? 64 + rr : 192 + (rr - 64));
        GAS v4u* p = (GAS v4u*)((bf16*)(ws + WS_DGU) + ((size_t)j * (2 * DFF_P) + drow) * DM); p[F.lane] = (v4u){0u, 0u, 0u, 0u}; p[64 + F.lane] = (v4u){0u, 0u, 0u, 0u}; } }
    { constexpr int IPM = (DFF / 64) * (DM / 32);
      for (int it = gw; it < 2 * IPM; it += NGW) { const int j = it / IPM, r = it % IPM;
        cvt_item<0, 0, false>(in[23] + (size_t)j * DFF * DM, DFF, DM, (bf16*)(ws + WS_DDN) + (size_t)j * DM * DFF_P, DFF_P, nullptr, nullptr, 0.f, scr, r, F.lane); }
      for (int it = gw * 64 + F.lane; it < 2 * DM * 8; it += NGW * 64) { const int j = it / (DM * 8), r = (it / 8) % DM, c = it % 8;
        *(GAS v4u*)((bf16*)(ws + WS_DDN) + ((size_t)j * DM + r) * DFF_P + DFF + 8 * c) = (v4u){0u, 0u, 0u, 0u}; } }
    { constexpr int IPM = (DM / 64) * (DFE / 32);
      for (int it = gw; it < 2 * NEXP * IPM; it += NGW) { const int je = it / IPM, r = it % IPM, j = je / NEXP; bf16* dst = (bf16*)(ws + WS_MGU) + (size_t)je * (2 * DFE) * DM;
        cvt_item<1, 1, false>(in[26] + (size_t)je * DM * DFE, DM, DFE, dst, DM, in[20] + (2 * j + 1) * DM, nullptr, 0.f, scr, r, F.lane);
        cvt_item<2, 1, false>(in[27] + (size_t)je * DM * DFE, DM, DFE, dst, DM, in[20] + (2 * j + 1) * DM, nullptr, 0.f, scr, r, F.lane); } }
    { constexpr int IPM = (DFE / 64) * (DM / 32);
      for (int it = gw; it < 2 * NEXP * IPM; it += NGW) { const int je = it / IPM, r = it % IPM;
        cvt_item<0, 0, false>(in[28] + (size_t)je * DFE * DM, DFE, DM, (bf16*)(ws + WS_MDN) + (size_t)je * DM * DFE, DFE, nullptr, nullptr, 0.f, scr, r, F.lane); } }
    for (int it = gw * 64 + F.lane; it < 2 * NEXP * DM; it += NGW * 64) { const int j = it / (NEXP * DM), e = (it / DM) % NEXP, c = it % DM;
        ((float*)(ws + WS_WR))[it] = in[20][(2 * j + 1) * DM + c] * in[24][((size_t)j * DM + c) * NEXP + e]; }
    { unsigned long long* ss = (unsigned long long*)(ws + WS_SS) + (size_t)SS_MIXN(0) * M;
      for (int m = gw; m < M; m += NGW) { const GAS f32x4* xr = (const GAS f32x4*)(in[0] + (size_t)m * DM) + F.lane; GAS f32x4* orow = (GAS f32x4*)(F.out + (size_t)m * DM) + F.lane;
        GAS unsigned long long* o8 = (GAS unsigned long long*)((bf16*)(ws + WS_XB) + (size_t)m * DM) + F.lane; float s = 0.f;
#pragma unroll
        for (int j = 0; j < 4; ++j) { const f32x4 v = xr[64 * j]; orow[64 * j] = v; s += (v.x * v.x + v.y * v.y) + (v.z * v.z + v.w * v.w);
            o8[64 * j] = (unsigned long long)pk2(v.x, v.y) | ((unsigned long long)pk2(v.z, v.w) << 32); }
        s = wave_sum(s); if (F.lane == 0) ss[m] = (unsigned long long)(s * SS_FX); } }
}

__device__ __forceinline__ float gelu_tanh(float y) {
    const float z = 0.7978845608028654f * (y + 0.044715f * y * y * y);
    const float t = 1.0f - 2.0f / (1.0f + __expf(2.0f * z));
    return 0.5f * y * (1.0f + t);
}
__device__ __forceinline__ void ssm_s1_unit(Frame& F, int L, int unit) {
    const int b = unit >> 5, g = unit & 31; const ArgView in;
    const bf16* Ug = (const bf16*)(F.ws + WS_UG); float* Yt = (float*)(F.ws + WS_YTMP);
    if (F.wave < 2) {
        const int d = F.wave, p = F.lane;
        LAS float* us = (LAS float*)(F.lds + d * 49152);
        LAS float* xs = us + 64 * 16;
        LAS float* cre = xs + 64 * 65 * 2;
        LAS float* cim = cre + 16 * 64;
        const int idx = (L * 2 + d) * SSM_G + g;
        const float lre = in[3][idx * SSM_P + p], lim = in[4][idx * SSM_P + p], step = expf(in[5][idx]);
        const float er = expf(lre * step), lbr = er * cosf(lim * step), lbi = er * sinf(lim * step);
        const float den = lre * lre + lim * lim, cr = ((lbr - 1.f) * lre + lbi * lim) / den, ci = (lbi * lre - (lbr - 1.f) * lim) / den;
        float bbr[16], bbi[16];
#pragma unroll
        for (int h = 0; h < 16; ++h) { const float br = in[6][((size_t)idx * SSM_P + p) * 16 + h], bi = in[7][((size_t)idx * SSM_P + p) * 16 + h];
            bbr[h] = cr * br - ci * bi; bbi[h] = cr * bi + ci * br; }
#pragma unroll
        for (int h = 0; h < 16; ++h) { cre[h * 64 + p] = in[8][((size_t)idx * 16 + h) * SSM_P + p]; cim[h * 64 + p] = in[9][((size_t)idx * 16 + h) * SSM_P + p]; }
        float xr = 0.f, xi = 0.f;
        for (int blk = 0; blk < SEQ / 64; ++blk) {
            const int tb = d == 0 ? blk : (SEQ / 64 - 1 - blk), t0 = tb * 64;
            { const GAS v4u* up = (const GAS v4u*)(Ug + ((size_t)g * M + (size_t)b * SEQ + t0 + F.lane) * 16); const v4u a = up[0], c = up[1];
              LAS float* u = us + F.lane * 16;
              u[0] = __uint_as_float(a.x << 16); u[1] = __uint_as_float(a.x & 0xffff0000u); u[2] = __uint_as_float(a.y << 16); u[3] = __uint_as_float(a.y & 0xffff0000u);
              u[4] = __uint_as_float(a.z << 16); u[5] = __uint_as_float(a.z & 0xffff0000u); u[6] = __uint_as_float(a.w << 16); u[7] = __uint_as_float(a.w & 0xffff0000u);
              u[8] = __uint_as_float(c.x << 16); u[9] = __uint_as_float(c.x & 0xffff0000u); u[10] = __uint_as_float(c.y << 16); u[11] = __uint_as_float(c.y & 0xffff0000u);
              u[12] = __uint_as_float(c.z << 16); u[13] = __uint_as_float(c.z & 0xffff0000u); u[14] = __uint_as_float(c.w << 16); u[15] = __uint_as_float(c.w & 0xffff0000u); }
            LDS_WAIT(); asm volatile("" ::: "memory");
            for (int s = 0; s < 64; ++s) { const int t = d == 0 ? s : 63 - s; const LAS float* u = us + t * 16; float bur = 0.f, bui = 0.f;
#pragma unroll
                for (int h = 0; h < 16; ++h) { const float uv = u[h]; bur = fmaf(bbr[h], uv, bur); bui = fmaf(bbi[h], uv, bui); }
                const float nxr = lbr * xr - lbi * xi + bur, nxi = lbr * xi + lbi * xr + bui; xr = nxr; xi = nxi;
                xs[(t * 65 + p) * 2] = xr; xs[(t * 65 + p) * 2 + 1] = xi; }
            LDS_WAIT(); asm volatile("" ::: "memory");
            float y[16];
#pragma unroll
            for (int h = 0; h < 16; ++h) y[h] = 0.f;
            for (int pp = 0; pp < 64; ++pp) { const float vr = xs[(F.lane * 65 + pp) * 2], vi = xs[(F.lane * 65 + pp) * 2 + 1];
#pragma unroll
                for (int h = 0; h < 16; ++h) y[h] += cre[h * 64 + pp] * vr - cim[h * 64 + pp] * vi; }
            GAS f32x4* yo = (GAS f32x4*)(Yt + ((size_t)d * M + (size_t)b * SEQ + t0 + F.lane) * SSM_W + g * 16);
            yo[0] = (f32x4){y[0], y[1], y[2], y[3]}; yo[1] = (f32x4){y[4], y[5], y[6], y[7]}; yo[2] = (f32x4){y[8], y[9], y[10], y[11]}; yo[3] = (f32x4){y[12], y[13], y[14], y[15]};
            LDS_WAIT(); asm volatile("" ::: "memory");
        }
    }
    VM_WAIT(); __syncthreads();
    { bf16* Y = (bf16*)(F.ws + WS_Y);
      for (int t = F.tid; t < SEQ; t += NWAVES * 64) { const size_t row = (size_t)b * SEQ + t;
        const GAS f32x4* y0 = (const GAS f32x4*)(Yt + row * SSM_W + g * 16); const GAS f32x4* y1 = (const GAS f32x4*)(Yt + ((size_t)M + row) * SSM_W + g * 16);
        const GAS v4u* up = (const GAS v4u*)(Ug + ((size_t)g * M + row) * 16); const v4u ua = up[0], ub = up[1];
        const unsigned uw[8] = {ua.x, ua.y, ua.z, ua.w, ub.x, ub.y, ub.z, ub.w}; unsigned ow[8];
#pragma unroll
        for (int q = 0; q < 4; ++q) { const f32x4 a = y0[q], c = y1[q]; const f32x4 dsk = *(const f32x4*)(in[10] + L * SSM_W + g * 16 + 4 * q);
            const float u0 = __uint_as_float(uw[2 * q] << 16), u1 = __uint_as_float(uw[2 * q] & 0xffff0000u), u2 = __uint_as_float(uw[2 * q + 1] << 16), u3 = __uint_as_float(uw[2 * q + 1] & 0xffff0000u);
            const float v0 = gelu_tanh(a.x + c.x + dsk.x * u0), v1 = gelu_tanh(a.y + c.y + dsk.y * u1), v2 = gelu_tanh(a.z + c.z + dsk.z * u2), v3 = gelu_tanh(a.w + c.w + dsk.w * u3);
            ow[2 * q] = pk2(v0, v1); ow[2 * q + 1] = pk2(v2, v3); }
        GAS v4u* yo = (GAS v4u*)(Y + row * SSM_W + g * 16); yo[0] = (v4u){ow[0], ow[1], ow[2], ow[3]}; yo[1] = (v4u){ow[4], ow[5], ow[6], ow[7]}; } }
    __syncthreads();
}

__device__ __forceinline__ void attn_unit(Frame& F, int L, int unit) {
    using namespace att;
    const int qb = unit & 15, h = (unit >> 4) & 3, b = unit >> 6;
    const int tid = F.tid, wid = tid >> 6, lane = tid & 63, r32 = lane & 31, hi = lane >> 5;
    const att::bf16* Qb = (const att::bf16*)(F.ws + WS_Q); const att::bf16* Kb = (const att::bf16*)(F.ws + WS_K); const att::bf16* Vb = (const att::bf16*)(F.ws + WS_V);
    float* At = (float*)(F.ws + WS_ATMP); att::bf16* MIX = (att::bf16*)(F.ws + WS_MIX);
    const unsigned long long* ssg = (const unsigned long long*)(F.ws + WS_SS) + (size_t)SS_GLU(L) * M;
    const ArgView in;
    const float d1 = wave_sum(in[14][L * 64 + lane] * in[15][L * 64 + lane]), d2 = wave_sum(in[16][L * 64 + lane] * in[17][L * 64 + lane]);
    const float lam = expf(d1) - expf(d2) + lambda_init(L);
    const float nsl2 = -exp2f(-2.0f * (float)(h + 1)) * 1.4426950408889634f;
    const size_t rowb = (size_t)b * SEQ; const int q0 = qb * 256;
    att::lchar* lds = (att::lchar*)(F.lds + RING_OFF);
    att::lfloat* ws = (att::lfloat*)(lds + 2 * SHM_V + 2 * SHM_K) + wid * 64;
    float* Aw = At + (rowb + q0 + wid * 32) * 512 + h * 128;
    att::bf16* Ow = MIX + (rowb + q0 + wid * 32) * DM + 512 + h * 128;
#pragma unroll 1
    for (int mp = 0; mp < 2; ++mp) {
        f32x16 o[4]; float l;
        attn_pass(Qb + (rowb + q0 + wid * 32) * LDQ + h * 128 + mp * 64, Kb + rowb * LDQ + h * 128 + mp * 64, Vb + rowb * LDQ + h * 128, q0, nsl2, lds, o, l);
        if (hi == 0) ws[r32] = l; asm volatile("s_waitcnt lgkmcnt(0)" ::: "memory");
        if (mp == 0) {
#pragma unroll
            for (int r = 0; r < 16; ++r) { const int orow = crow(r, hi); const float rl = __builtin_amdgcn_rcpf(ws[orow]);
                float* awp = Aw + (size_t)(4 * hi) * 512 + r32; asm volatile("" : "+v"(awp));
#pragma unroll
                for (int d0 = 0; d0 < 4; ++d0) awp[crow(r, 0) * 512 + d0 * 32] = o[d0][r] * rl; }
        } else {
#pragma unroll
            for (int r = 0; r < 16; ++r) { const int orow = crow(r, hi); const float rl = __builtin_amdgcn_rcpf(ws[orow]) * lam; float v[4]; float sq = 0.f;
                const float* awp = Aw + (size_t)(4 * hi) * 512 + r32; asm volatile("" : "+v"(awp));
#pragma unroll
                for (int d0 = 0; d0 < 4; ++d0) { v[d0] = awp[crow(r, 0) * 512 + d0 * 32] - o[d0][r] * rl; sq += v[d0] * v[d0]; }
                sq += __shfl_xor(sq, 1); sq += __shfl_xor(sq, 2); sq += __shfl_xor(sq, 4); sq += __shfl_xor(sq, 8); sq += __shfl_xor(sq, 16);
                const unsigned long long* ssp = ssg + rowb + q0 + wid * 32 + 4 * hi; asm volatile("" : "+v"(ssp));
                const float invrg = sqrtf((float)ssp[crow(r, 0)] * SS_FX_INV * (1.0f / SSM_W) + NORM_EPS);
                const float sc = invrg / sqrtf(sq * (1.0f / ATT_DV) + NORM_EPS);
                att::bf16* owp = Ow + (size_t)(4 * hi) * DM + r32; asm volatile("" : "+v"(owp));
#pragma unroll
                for (int d0 = 0; d0 < 4; ++d0) owp[crow(r, 0) * DM + d0 * 32] = (att::bf16)f2bf(v[d0] * sc); }
        }
        asm volatile("s_waitcnt vmcnt(0) lgkmcnt(0)" ::: "memory");
        __syncthreads();
    }
}

__device__ __forceinline__ void moe_route(Frame& F, int j) {
    const float* wr = (const float*)(F.ws + WS_WR) + (size_t)j * NEXP * DM; const float* br = (const float*)argt(25) + j * NEXP;
    int* r_e = (int*)(F.ws + WS_ROUTE); int* r_pos = r_e + 2 * M; float* r_w = (float*)(r_pos + 2 * M);
    gu32* cnt = F.ctl + CW_ROUTE + j * 64;
    LAS unsigned* lcnt = (LAS unsigned*)(F.lds + RING_OFF);
    if (F.tid < 16) lcnt[F.tid] = 0u;
    __syncthreads();
    const int gw = F.vcu * NWAVES + F.wave, NGW = F.G * NWAVES;
    for (int base = 0; base < M; base += NGW * 16) {
        int my_e0 = 0, my_e1 = 0, my_l0 = 0, my_l1 = 0; float my_w0 = 0.f, my_w1 = 0.f; int my_row = -1;
        for (int jj = 0; jj < 16; ++jj) { const int m = base + jj * NGW + gw; if (m >= M) break;
            const GAS f32x4* xr = (const GAS f32x4*)(F.out + (size_t)m * DM) + F.lane; f32x4 v[4]; float s = 0.f;
#pragma unroll
            for (int q = 0; q < 4; ++q) { v[q] = xr[64 * q]; s += (v[q].x * v[q].x + v[q].y * v[q].y) + (v[q].z * v[q].z + v[q].w * v[q].w); }
            const float r = 1.0f / sqrtf(wave_sum(s) * (1.0f / DM) + NORM_EPS);
            float lg[NEXP];
#pragma unroll
            for (int e = 0; e < NEXP; ++e) { const GAS f32x4* we = (const GAS f32x4*)(wr + (size_t)e * DM) + F.lane; float d = 0.f;
#pragma unroll
                for (int q = 0; q < 4; ++q) { const f32x4 w = we[64 * q]; d += (v[q].x * w.x + v[q].y * w.y) + (v[q].z * w.z + v[q].w * w.w); }
                lg[e] = wave_sum(d) * r + br[e]; }
            int i0 = 0; float v0 = lg[0];
#pragma unroll
            for (int e = 1; e < NEXP; ++e) if (lg[e] > v0) { v0 = lg[e]; i0 = e; }
            int i1 = -1; float v1 = -3.0e38f;
#pragma unroll
            for (int e = 0; e < NEXP; ++e) if (e != i0 && lg[e] > v1) { v1 = lg[e]; i1 = e; }
            const float w0 = 1.0f / (1.0f + expf(v1 - v0)), w1 = 1.0f - w0;
            unsigned l0 = 0u, l1 = 0u;
            if (F.lane == 0) { l0 = __hip_atomic_fetch_add(lcnt + i0, 1u, __ATOMIC_RELAXED, __HIP_MEMORY_SCOPE_WORKGROUP); l1 = __hip_atomic_fetch_add(lcnt + i1, 1u, __ATOMIC_RELAXED, __HIP_MEMORY_SCOPE_WORKGROUP); }
            l0 = __shfl(l0, 0); l1 = __shfl(l1, 0);
            if (F.lane == jj) { my_e0 = i0; my_e1 = i1; my_l0 = (int)l0; my_l1 = (int)l1; my_w0 = w0; my_w1 = w1; my_row = m; }
        }
        __syncthreads();
        if (F.tid < NEXP) { const unsigned n = lcnt[F.tid]; lcnt[8 + F.tid] = n ? __hip_atomic_fetch_add(cnt + F.tid, n, RLX_AGENT) : 0u; }
        __syncthreads();
        if (my_row >= 0) { r_e[2 * my_row] = my_e0; r_e[2 * my_row + 1] = my_e1; r_pos[2 * my_row] = (int)lcnt[8 + my_e0] + my_l0; r_pos[2 * my_row + 1] = (int)lcnt[8 + my_e1] + my_l1;
                           r_w[2 * my_row] = my_w0; r_w[2 * my_row + 1] = my_w1; }
        __syncthreads();
        if (F.tid < 8) lcnt[F.tid] = 0u;
        __syncthreads();
    }
}
__device__ __forceinline__ void moe_tile_offsets(Frame& F, int j, int (&toff)[9]) {
    gu32* cnt = F.ctl + CW_ROUTE + j * 64; int acc = 0;
#pragma unroll
    for (int e = 0; e < NEXP; ++e) { toff[e] = acc; const unsigned n = __builtin_amdgcn_readfirstlane(__hip_atomic_load(cnt + e, RLX_AGENT)); acc += (int)((n + 255u) >> 8); }
    toff[8] = acc;
}
__device__ __forceinline__ void moe_gather(Frame& F, int j) {
    int toff[9]; moe_tile_offsets(F, j, toff);
    int* r_e = (int*)(F.ws + WS_ROUTE); int* r_pos = r_e + 2 * M;
    bf16* XG = (bf16*)(F.ws + WS_XG);
    const int gw = F.vcu * NWAVES + F.wave, NGW = F.G * NWAVES;
    for (int m = gw; m < M; m += NGW) {
        const GAS f32x4* xr = (const GAS f32x4*)(F.out + (size_t)m * DM) + F.lane; f32x4 v[4]; float s = 0.f;
#pragma unroll
        for (int q = 0; q < 4; ++q) { v[q] = xr[64 * q]; s += (v[q].x * v[q].x + v[q].y * v[q].y) + (v[q].z * v[q].z + v[q].w * v[q].w); }
        const float r = 1.0f / sqrtf(wave_sum(s) * (1.0f / DM) + NORM_EPS);
#pragma unroll
        for (int k = 0; k < 2; ++k) { const int e = r_e[2 * m + k], pos = r_pos[2 * m + k]; int t0 = 0;
#pragma unroll
            for (int q = 0; q < NEXP; ++q) t0 = (e == q) ? toff[q] : t0;
            const int dest = t0 * 256 + pos;
            GAS unsigned long long* o8 = (GAS unsigned long long*)(XG + (size_t)dest * DM) + F.lane;
#pragma unroll
            for (int q = 0; q < 4; ++q) o8[64 * q] = (unsigned long long)pk2(v[q].x * r, v[q].y * r) | ((unsigned long long)pk2(v[q].z * r, v[q].w * r) << 32);
            if (F.lane == 0) r_pos[2 * m + k] = dest; }
    }
}
__device__ __forceinline__ void moe_combine(Frame& F, int L, bool last) {
    const int* r_e = (const int*)(F.ws + WS_ROUTE); const int* r_pos = r_e + 2 * M; const float* r_w = (const float*)(r_pos + 2 * M);
    const bf16* YE = (const bf16*)(F.ws + WS_XG);
    unsigned long long* ss = (unsigned long long*)(F.ws + WS_SS) + (size_t)SS_MIXN(last ? 0 : L + 1) * M;
    const int gw = F.vcu * NWAVES + F.wave, NGW = F.G * NWAVES;
    for (int m = gw; m < M; m += NGW) {
        GAS f32x4* xr = (GAS f32x4*)(F.out + (size_t)m * DM) + F.lane;
        const int d0 = r_pos[2 * m], d1 = r_pos[2 * m + 1]; const float w0 = r_w[2 * m], w1 = r_w[2 * m + 1];
        const GAS unsigned long long* y0 = (const GAS unsigned long long*)(YE + (size_t)d0 * DM) + F.lane; const GAS unsigned long long* y1 = (const GAS unsigned long long*)(YE + (size_t)d1 * DM) + F.lane;
        f32x4 v[4]; float s = 0.f;
#pragma unroll
        for (int q = 0; q < 4; ++q) { const f32x4 x = xr[64 * q]; const unsigned long long a = y0[64 * q], c = y1[64 * q];
            const unsigned a0 = (unsigned)a, a1 = (unsigned)(a >> 32), c0 = (unsigned)c, c1 = (unsigned)(c >> 32);
            v[q].x = x.x + w0 * __uint_as_float(a0 << 16) + w1 * __uint_as_float(c0 << 16);
            v[q].y = x.y + w0 * __uint_as_float(a0 & 0xffff0000u) + w1 * __uint_as_float(c0 & 0xffff0000u);
            v[q].z = x.z + w0 * __uint_as_float(a1 << 16) + w1 * __uint_as_float(c1 << 16);
            v[q].w = x.w + w0 * __uint_as_float(a1 & 0xffff0000u) + w1 * __uint_as_float(c1 & 0xffff0000u);
            s += (v[q].x * v[q].x + v[q].y * v[q].y) + (v[q].z * v[q].z + v[q].w * v[q].w); }
        s = wave_sum(s);
        if (!last) {
            GAS unsigned long long* o8 = (GAS unsigned long long*)((bf16*)(F.ws + WS_XB) + (size_t)m * DM) + F.lane;
#pragma unroll
            for (int q = 0; q < 4; ++q) { xr[64 * q] = v[q]; o8[64 * q] = (unsigned long long)pk2(v[q].x, v[q].y) | ((unsigned long long)pk2(v[q].z, v[q].w) << 32); }
            if (F.lane == 0) ss[m] = (unsigned long long)(s * SS_FX);
        } else {
            const float r = 1.0f / sqrtf(s * (1.0f / DM) + NORM_EPS); const GAS f32x4* gf = (const GAS f32x4*)argt(29) + F.lane;
#pragma unroll
            for (int q = 0; q < 4; ++q) { const f32x4 gq = gf[64 * q]; xr[64 * q] = (f32x4){v[q].x * r * gq.x, v[q].y * r * gq.y, v[q].z * r * gq.z, v[q].w * r * gq.w}; }
        }
    }
}

#ifndef EN_ALL
#define EN_ALL 1
#endif
#ifndef EN_P0
#define EN_P0 EN_ALL
#endif
#ifndef EN_INPROJ
#define EN_INPROJ EN_ALL
#endif
#ifndef EN_SSM
#define EN_SSM EN_ALL
#endif
#ifndef EN_GLU
#define EN_GLU EN_ALL
#endif
#ifndef EN_ATT
#define EN_ATT EN_ALL
#endif
#ifndef EN_OUT
#define EN_OUT EN_ALL
#endif
#ifndef EN_DGU
#define EN_DGU EN_ALL
#endif
#ifndef EN_DDN
#define EN_DDN EN_ALL
#endif
#ifndef EN_ROUTE
#define EN_ROUTE EN_ALL
#endif
#ifndef EN_MGU
#define EN_MGU EN_ALL
#endif
#ifndef EN_MDN
#define EN_MDN EN_ALL
#endif

#define PHASE_FN __device__ __forceinline__ void
PHASE_FN ph_prologue() { Frame F = make_frame(); p0_prologue(F); }
PHASE_FN ph_inproj(int L) {
    Frame F = make_frame(); unsigned char* ws = F.ws; unsigned long long* SS = (unsigned long long*)(ws + WS_SS);
    pg8::Gemm g{(const bf16*)(ws + WS_XB), (const bf16*)(ws + WS_WIN) + (size_t)L * IN_COLS * DM, M, IN_COLS, DM, 0}; pg8::StaticOrder S; S.init(M, IN_COLS, F.G, (int)blockIdx.x);
    pg8::EpiInProj E{(bf16*)(ws + WS_UG), (bf16*)(ws + WS_Q), (size_t)(WS_K - WS_Q) / 2, SS + (size_t)SS_MIXN(L) * M};
    static_assert(WS_V - WS_K == WS_K - WS_Q, "q | k | v sections equally spaced");
    pg8::gemm_phase<pg8::EpiInProj, pg8::StaticOrder, true, true>(F.lds + RING_OFF, g, S, E);
}
PHASE_FN ph_ssm(int L) { Frame F = make_frame(); for (int u = blockIdx.x; u < BATCH * SSM_G; u += F.G) ssm_s1_unit(F, L, u); }
PHASE_FN ph_glu(int L) {
    Frame F = make_frame(); unsigned char* ws = F.ws; unsigned long long* SS = (unsigned long long*)(ws + WS_SS);
    pg8::Gemm g{(const bf16*)(ws + WS_Y), (const bf16*)(ws + WS_WGLU) + (size_t)L * SSM_W * SSM_W, M, SSM_W, SSM_W, 0}; pg8::StaticOrder S; S.init(M, SSM_W, F.G, (int)blockIdx.x);
    pg8::EpiGLU E{(const bf16*)(ws + WS_Y), (bf16*)(ws + WS_MIX), (const float*)argt(12) + L * SSM_W, SS + (size_t)SS_GLU(L) * M};
    pg8::gemm_phase<pg8::EpiGLU, pg8::StaticOrder, true, true>(F.lds + RING_OFF, g, S, E);
}
PHASE_FN ph_attn(int L) { Frame F = make_frame(); for (int u = F.vcu; u < BATCH * ATT_H * (SEQ / 256); u += F.G) attn_unit(F, L, u); }
PHASE_FN ph_outproj(int L) {
    Frame F = make_frame(); unsigned char* ws = F.ws; unsigned long long* SS = (unsigned long long*)(ws + WS_SS);
    pg8::Gemm g{(const bf16*)(ws + WS_MIX), (const bf16*)(ws + WS_WOUT) + (size_t)L * DM * DM, M, DM, DM, 0}; pg8::StaticOrder S; S.init(M, DM, F.G, (int)blockIdx.x);
    pg8::EpiResid E{F.out, (bf16*)(ws + WS_XB), SS + (size_t)SS_GLU(L) * M, 1.0f / SSM_W, SS + (size_t)SS_FFN(L) * M};
    pg8::gemm_phase<pg8::EpiResid, pg8::StaticOrder, true, true>(F.lds + RING_OFF, g, S, E);
}
PHASE_FN ph_dense_gu(int L) {
    Frame F = make_frame(); unsigned char* ws = F.ws; unsigned long long* SS = (unsigned long long*)(ws + WS_SS); const int j = L >> 1;
    pg8::Gemm g{(const bf16*)(ws + WS_XB), (const bf16*)(ws + WS_DGU) + (size_t)j * (2 * DFF_P) * DM, M, 2 * DFF_P, DM, 0}; pg8::StaticOrder S; S.init(M, 2 * DFF_P, F.G, (int)blockIdx.x);
    pg8::EpiGateUp E{(bf16*)(ws + WS_HD), DFF_P, SS + (size_t)SS_FFN(L) * M};
    pg8::gemm_phase<pg8::EpiGateUp, pg8::StaticOrder, true, true>(F.lds + RING_OFF, g, S, E);
}
PHASE_FN ph_dense_dn(int L) {
    Frame F = make_frame(); unsigned char* ws = F.ws; unsigned long long* SS = (unsigned long long*)(ws + WS_SS); const int j = L >> 1;
    pg8::Gemm g{(const bf16*)(ws + WS_HD), (const bf16*)(ws + WS_DDN) + (size_t)j * DM * DFF_P, M, DM, DFF_P, 0}; pg8::StaticOrder S; S.init(M, DM, F.G, (int)blockIdx.x);
    pg8::EpiResid E{F.out, (bf16*)(ws + WS_XB), nullptr, 0.f, SS + (size_t)SS_MIXN(L + 1) * M};
    pg8::gemm_phase<pg8::EpiResid, pg8::StaticOrder, true, true>(F.lds + RING_OFF, g, S, E);
}
PHASE_FN ph_route(int j) { Frame F = make_frame(); moe_route(F, j); }
PHASE_FN ph_gather(int j) { Frame F = make_frame(); moe_gather(F, j); }
PHASE_FN ph_moe_gu(int j, int ch) {
    Frame F = make_frame(); unsigned char* ws = F.ws;
    pg8::ChunkOrder S; moe_tile_offsets(F, j, S.toff);
    const int tlo = ch * HM_TILES, thi = (S.toff[8] < tlo + HM_TILES) ? S.toff[8] : tlo + HM_TILES, nT = thi > tlo ? thi - tlo : 0;
    S.nM = nT; S.nN = (2 * DFE) / 256; S.nwg = S.nM * S.nN; S.G = F.G; S.c = (int)blockIdx.x; S.tlo = tlo;
    pg8::Gemm g{(const bf16*)(ws + WS_XG), (const bf16*)(ws + WS_MGU) + (size_t)j * NEXP * (2 * DFE) * DM, MOE_ROWS, 2 * DFE, DM, (size_t)(2 * DFE) * DM * 2};
    pg8::EpiGateUp E{(bf16*)(ws + WS_HM) - (size_t)tlo * 256 * DFE, DFE, nullptr};
    pg8::gemm_phase<pg8::EpiGateUp, pg8::ChunkOrder, true, true>(F.lds + RING_OFF, g, S, E);
}
PHASE_FN ph_moe_dn(int j, int ch) {
    Frame F = make_frame(); unsigned char* ws = F.ws;
    pg8::ChunkOrder S; moe_tile_offsets(F, j, S.toff);
    const int tlo = ch * HM_TILES, thi = (S.toff[8] < tlo + HM_TILES) ? S.toff[8] : tlo + HM_TILES, nT = thi > tlo ? thi - tlo : 0;
    S.nM = nT; S.nN = DM / 256; S.nwg = S.nM * S.nN; S.G = F.G; S.c = (int)blockIdx.x; S.tlo = tlo;
    pg8::Gemm g{(const bf16*)(ws + WS_HM) - (size_t)tlo * 256 * DFE, (const bf16*)(ws + WS_MDN) + (size_t)j * NEXP * DM * DFE, MOE_ROWS, DM, DFE, (size_t)DM * DFE * 2};
    pg8::EpiStoreBf16 E{(bf16*)(ws + WS_XG), DM};
    pg8::gemm_phase<pg8::EpiStoreBf16, pg8::ChunkOrder, true, true>(F.lds + RING_OFF, g, S, E);
}
PHASE_FN ph_combine(int L) { Frame F = make_frame(); moe_combine(F, L, L == DEPTH - 1); }

constexpr int N_PHASE_IDS = 1 + 12 * DEPTH;
__global__ void __launch_bounds__(NWAVES * 64, 2) fwd_kernel(Args args) {
    LAS unsigned char* lds = (LAS unsigned char*)g_lds;
    for (int u = threadIdx.x; u < (LDS_BYTES - LDSCTL_OFF) / 4; u += NWAVES * 64) ((LAS unsigned*)(lds + LDSCTL_OFF))[u] = 0u;
    __syncthreads();
    if (threadIdx.x < 32) { unsigned long long v;
        if (threadIdx.x < 30) v = (unsigned long long)args.in[threadIdx.x < 30 ? threadIdx.x : 0]; else if (threadIdx.x == 30) v = (unsigned long long)args.out; else v = (unsigned long long)args.ws;
        ((LAS unsigned long long*)(lds + ARGT_OFF))[threadIdx.x] = v; }
    __syncthreads();
    XcdBarrier bar = xcd_barrier_post((unsigned*)((gu32*)(args.ws + WS_CTL) + CW_BAR), (volatile LAS unsigned*)(lds + MISC_OFF) + 8);
    const int lo = args.ph_lo, hi = args.ph_hi;
#define IN(k) (lo <= (k) && (k) < hi)
#define SEAM(k) do { if (hi > (k) + 1) xcd_barrier(bar); } while (0)
    if (EN_P0 && IN(0)) { ph_prologue(); SEAM(0); }
#pragma unroll 1
    for (int L = 0; L < DEPTH; ++L) {
        const int pb = 1 + 12 * L;
        if (EN_INPROJ && IN(pb + 0)) { ph_inproj(L); SEAM(pb + 0); }
        if (EN_SSM && IN(pb + 1)) { ph_ssm(L); SEAM(pb + 1); }
        if (EN_GLU && IN(pb + 2)) { ph_glu(L); SEAM(pb + 2); }
        if (EN_ATT && IN(pb + 3)) { ph_attn(L); SEAM(pb + 3); }
        if (EN_OUT && IN(pb + 4)) { ph_outproj(L); SEAM(pb + 4); }
        if ((L & 1) == 0) {
            if (EN_DGU && IN(pb + 5)) { ph_dense_gu(L); SEAM(pb + 5); }
            if (EN_DDN && IN(pb + 6)) { ph_dense_dn(L); SEAM(pb + 6); }
        } else {
            const int j = L >> 1;
            if (EN_ROUTE && IN(pb + 5)) { ph_route(j); SEAM(pb + 5); }
            if (EN_ROUTE && IN(pb + 6)) { ph_gather(j); SEAM(pb + 6); }
#pragma unroll 1
            for (int ch = 0; ch < 2; ++ch) {
                if (EN_MGU && IN(pb + 7 + 2 * ch)) { ph_moe_gu(j, ch); SEAM(pb + 7 + 2 * ch); }
                if (EN_MDN && IN(pb + 8 + 2 * ch)) { ph_moe_dn(j, ch); SEAM(pb + 8 + 2 * ch); }
            }
            if (EN_ROUTE && IN(pb + 11)) { ph_combine(L); SEAM(pb + 11); }
        }
    }
#undef IN
#undef SEAM
}

extern "C" void kernel_launch(void* const* d_in, const int* in_sizes, int n_in, void* d_out, int out_size, void* d_ws, size_t ws_size, hipStream_t stream) {
    static int grid = 0;
    if (grid == 0) {
        if (n_in != 30 || in_sizes[0] != M * DM || out_size != M * DM || ws_size < WS_END || ws_size < WS_YTMP + 128 * MiB) {
            fprintf(stderr, "kernel_launch: unexpected shapes (n_in %d, in0 %d, out %d, ws %zu; need ws >= %zu); nothing launched\n", n_in, n_in > 0 ? in_sizes[0] : -1, out_size, ws_size, (size_t)WS_END); grid = -1; return; }
        int dev = 0, cus = 0, per_cu = 0;
        if (hipGetDevice(&dev) != hipSuccess || hipDeviceGetAttribute(&cus, hipDeviceAttributeMultiprocessorCount, dev) != hipSuccess) { grid = -1; return; }
        if (hipFuncSetAttribute((const void*)fwd_kernel, hipFuncAttributeMaxDynamicSharedMemorySize, LDS_BYTES) != hipSuccess) { fprintf(stderr, "kernel_launch: hipFuncSetAttribute failed\n"); grid = -1; return; }
        if (hipOccupancyMaxActiveBlocksPerMultiprocessor(&per_cu, (const void*)fwd_kernel, NWAVES * 64, LDS_BYTES) != hipSuccess || per_cu < 1) { fprintf(stderr, "kernel_launch: occupancy query says %d\n", per_cu); }
        (void)hipGetLastError();
        grid = cus;
    }
    if (grid < 0) return;
    (void)hipMemsetAsync((char*)d_ws, 0, ZERO_BYTES, stream);
    Args a{};
    for (int i = 0; i < 30; ++i) a.in[i] = (const float*)d_in[i];
    a.out = (float*)d_out; a.ws = (unsigned char*)d_ws;
#ifndef MK_ONE_LAUNCH
#define MK_ONE_LAUNCH 0
#endif
    if (MK_ONE_LAUNCH) { a.ph_lo = 0; a.ph_hi = N_PHASE_IDS; hipLaunchKernelGGL(fwd_kernel, dim3(grid), dim3(NWAVES * 64), LDS_BYTES, stream, a); }
    else {
        for (int p = 0; p < N_PHASE_IDS; ++p) {
            if (p > 0) { const int L = (p - 1) / 12, k = (p - 1) % 12; if ((L & 1) == 0 && k >= 7) continue; }
            a.ph_lo = p; a.ph_hi = p + 1;
            hipLaunchKernelGGL(fwd_kernel, dim3(grid), dim3(NWAVES * 64), LDS_BYTES, stream, a);
        }
    }
    const hipError_t le = hipPeekAtLastError();
    if (le != hipSuccess) fprintf(stderr, "kernel_launch: launch failed: %s\n", hipGetErrorName(le));
}
```

```cpp
#include <hip/hip_runtime.h>
#include <hip/hip_bf16.h>
#include <cstdio>
#include <cstdint>
#include <cmath>

constexpr int BATCH = 8, SEQ = 4096, DM = 1024, DEPTH = 4;
constexpr int M = BATCH * SEQ;
constexpr int SSM_W = 512, SSM_G = 32, SSM_GC = 16, SSM_P = 64;
constexpr int ATT_W = 512, ATT_H = 4, ATT_D = 64, ATT_DV = 128;
constexpr int IN_COLS = 2048;
constexpr int DFF = 2752, DFF_P = 2816;
constexpr int NEXP = 8, DFE = 3584;
constexpr float NORM_EPS = 1e-6f;
constexpr float QSCALE = 0.125f * 1.4426950408889634f;
constexpr float SS_FX = 16777216.0f, SS_FX_INV = 1.0f / 16777216.0f;

namespace pg8 {
#define PG8_LAS __attribute__((address_space(3)))
#define PG8_GAS __attribute__((address_space(1)))
typedef unsigned short bf16_t;
typedef short bf16x8 __attribute__((ext_vector_type(8)));
typedef float f32x4 __attribute__((ext_vector_type(4)));
typedef float f32x2 __attribute__((ext_vector_type(2)));
typedef unsigned u32x4 __attribute__((ext_vector_type(4)));
typedef unsigned u32x2 __attribute__((ext_vector_type(2)));
typedef int v4i32 __attribute__((ext_vector_type(4)));
constexpr int BM = 256, BK = 64, HALF = 128, HTB = HALF * BK * 2  , STAGE_BYTES = 8 * HTB, NXCD = 8, WGM = 8;

__host__ __device__ __forceinline__ int lds_byte(int r, int c) { const int st = (r >> 4) * 2 + (c >> 5), rr = r & 15, cc = c & 31, ob = rr * 64 + cc * 2; return st * 1024 + (ob ^ (((ob >> 9) & 1) << 5)); }
__host__ __device__ __forceinline__ void stage_rc(int b, int& R, int& C) { const int st = b / 1024, sb = b % 1024, swz = sb ^ (((sb >> 9) & 1) << 5); R = (st >> 1) * 16 + swz / 64; C = (st & 1) * 32 + (swz % 64) / 2; }
__host__ __device__ __forceinline__ int perm32(int rho) { const int n = rho >> 4, i = rho & 15; return 8 * (i >> 2) + 4 * n + (i & 3); }

struct Unit { int pm, pn, e; };
struct Gemm { const bf16_t* A; const bf16_t* Bt; int M, N, K; size_t be; };

struct StaticOrder {
    int nM, nN, nwg, G, c, rot;
    __host__ __device__ void init(int M_, int N_, int G_, int c_, int rot_ = 0) { nM = M_ / BM; nN = N_ / BM; nwg = nM * nN; G = G_; c = c_; rot = rot_; }
    __host__ __device__ bool next(int i, Unit& u) const {
        const long L = (long)i * G + c; if (L >= nwg) return false;
        int wgid = (int)L; { const int q = nwg / NXCD, r = nwg % NXCD, xcd = wgid % NXCD, off = wgid / NXCD; wgid = (xcd < r ? xcd * (q + 1) : r * (q + 1) + (xcd - r) * q) + off; }
        const int nig = WGM * nN, gid = wgid / nig, fm = gid * WGM, gsz = (nM - fm) < WGM ? (nM - fm) : WGM;
        u.pm = fm + ((wgid % nig) % gsz); u.pn = ((wgid % nig) / gsz + rot * gid) % nN; u.e = 0; return true;
    }
    __device__ __forceinline__ void a_ready(const Unit&) const {}
    __device__ __forceinline__ void done(const Unit&) const {}
};
struct ChunkOrder {
    int nM, nN, nwg, G, c, tlo; const PG8_LAS int* toff;
    __device__ bool next(int i, Unit& u) const {
        const long L = (long)i * G + c; if (L >= nwg) return false;
        int wgid = (int)L; { const int q = nwg / NXCD, r = nwg % NXCD, xcd = wgid % NXCD, off = wgid / NXCD; wgid = (xcd < r ? xcd * (q + 1) : r * (q + 1) + (xcd - r) * q) + off; }
        const int nig = WGM * nN, gid = wgid / nig, fm = gid * WGM, gsz = (nM - fm) < WGM ? (nM - fm) : WGM;
        u.pm = tlo + fm + ((wgid % nig) % gsz); u.pn = (wgid % nig) / gsz;
        int e = 0;
#pragma unroll
        for (int k = 1; k < 8; ++k) e += (u.pm >= toff[k]) ? 1 : 0;
        u.e = e; return true;
    }
    __device__ __forceinline__ void a_ready(const Unit&) const {}
    __device__ __forceinline__ void done(const Unit&) const {}
};

__device__ __forceinline__ unsigned cvt_pk_bf16(float lo, float hi) { unsigned r; asm volatile("v_cvt_pk_bf16_f32 %0, %1, %2" : "=v"(r) : "v"(lo), "v"(hi)); return r; }
__device__ __forceinline__ float bf_lo(unsigned w) { return __uint_as_float(w << 16); }
__device__ __forceinline__ float bf_hi(unsigned w) { return __uint_as_float(w & 0xffff0000u); }
__device__ __forceinline__ float rs_from_ss(const unsigned long long* ss, int row, float inv_n) {
    const unsigned long long v = *(const PG8_GAS unsigned long long*)(ss + row);
    return 1.0f / sqrtf((float)v * SS_FX_INV * inv_n + NORM_EPS);
}
__device__ __forceinline__ void rs8_from_ss(float (&rs)[8], const unsigned long long* ss, int row0, float inv_n) {
    if (ss) { unsigned long long v[8];
#pragma unroll
        for (int i = 0; i < 8; ++i) v[i] = *(const PG8_GAS unsigned long long*)(ss + row0 + (i >> 2) * HALF + (i & 3) * 16);
#pragma unroll
        for (int i = 0; i < 8; ++i) rs[i] = 1.0f / sqrtf((float)v[i] * SS_FX_INV * inv_n + NORM_EPS);
    } else {
#pragma unroll
        for (int i = 0; i < 8; ++i) rs[i] = 1.0f; }
}
__device__ __forceinline__ void ss_add(unsigned long long* ss, int row, float part) {
    __hip_atomic_fetch_add((PG8_GAS unsigned long long*)(ss + row), (unsigned long long)(part * SS_FX), __ATOMIC_RELAXED, __HIP_MEMORY_SCOPE_AGENT);
}
__device__ __forceinline__ float sum4sq(f32x4 v) { return (v[0] * v[0] + v[1] * v[1]) + (v[2] * v[2] + v[3] * v[3]); }
__device__ __forceinline__ f32x4 i32acc(f32x4 a) { const v4i32 v = __builtin_bit_cast(v4i32, a); return (f32x4){(float)v[0], (float)v[1], (float)v[2], (float)v[3]}; }

template <bool IACC>
struct EpiInProj {
    static constexpr bool PERM = true, AFTER_DRAIN = false;
    bf16_t* Ug; bf16_t* Q; size_t qkv_stride; const unsigned long long* ss; size_t vl_off, vr_off; unsigned* kmax; float descale;
    __device__ __forceinline__ void operator()(const f32x4 (&acc)[2][2][4][2], const Unit& u, int wr, int wc, int fr, int fq) const {
        const int row0 = u.pm * BM + wr * 64 + fr, ct = u.pn;
        float kmx[2] = {0.f, 0.f};
        float rs8[8]; if constexpr (IACC) {
#pragma unroll
            for (int i = 0; i < 8; ++i) rs8[i] = descale * ((ct == 2 || ct == 3) ? QSCALE : 1.0f); } else rs8_from_ss(rs8, ss, row0, 1.0f / DM);
#pragma unroll
        for (int ai = 0; ai < 2; ++ai)
#pragma unroll
            for (int m = 0; m < 4; ++m) { const int row = row0 + ai * HALF + m * 16; const float rs = rs8[ai * 4 + m];
#pragma unroll
                for (int bj = 0; bj < 2; ++bj) { const f32x4 v0 = (IACC ? i32acc(acc[ai][bj][m][0]) : acc[ai][bj][m][0]) * rs, v1 = (IACC ? i32acc(acc[ai][bj][m][1]) : acc[ai][bj][m][1]) * rs;
                    u32x4 w; w.x = cvt_pk_bf16(v0[0], v0[1]); w.y = cvt_pk_bf16(v0[2], v0[3]); w.z = cvt_pk_bf16(v1[0], v1[1]); w.w = cvt_pk_bf16(v1[2], v1[3]);
                    const int c0 = (ct & 1) * 256 + bj * HALF + wc * 32 + 8 * fq;
                    bf16_t* dst;
                    if (ct < 2) dst = Ug + ((size_t)(c0 >> 4) * M + row) * 16 + (c0 & 15);
                    else dst = Q + (size_t)((ct >> 1) - 1) * qkv_stride + (size_t)row * 512 + c0;
                    if (ct < 6) *(PG8_GAS u32x4*)dst = w;
                    if (ct >= 6) {
                        const int head = (ct & 1) * 2 + bj, kin = row & 63; const float sl2 = __builtin_amdgcn_exp2f(-2.0f * (float)(head + 1)) * 1.4426950408889634f;
                        const float wl = __builtin_amdgcn_exp2f(-sl2 * (float)(63 - kin)), wrr = __builtin_amdgcn_exp2f(-sl2 * (float)kin);
                        const f32x4 l0 = v0 * wl, l1 = v1 * wl, r0 = v0 * wrr, r1 = v1 * wrr;
                        u32x4 a; a.x = cvt_pk_bf16(l0[0], l0[1]); a.y = cvt_pk_bf16(l0[2], l0[3]); a.z = cvt_pk_bf16(l1[0], l1[1]); a.w = cvt_pk_bf16(l1[2], l1[3]);
                        u32x4 c; c.x = cvt_pk_bf16(r0[0], r0[1]); c.y = cvt_pk_bf16(r0[2], r0[3]); c.z = cvt_pk_bf16(r1[0], r1[1]); c.w = cvt_pk_bf16(r1[2], r1[3]);
                        *(PG8_GAS u32x4*)(dst + vl_off) = a; *(PG8_GAS u32x4*)(dst + vr_off) = c;
                    } else if (ct >= 4) {
                        float s = sum4sq(v0) + sum4sq(v1); s += __shfl_xor(s, 16); s += __shfl_xor(s, 32); kmx[bj] = fmaxf(kmx[bj], s);
                    } }
                asm volatile("" ::: "memory"); }
        if (ct >= 4 && ct < 6) {
#pragma unroll
            for (int bj = 0; bj < 2; ++bj) { float s = kmx[bj]; s = fmaxf(s, __shfl_xor(s, 1)); s = fmaxf(s, __shfl_xor(s, 2)); s = fmaxf(s, __shfl_xor(s, 4)); s = fmaxf(s, __shfl_xor(s, 8));
                const int head = (ct & 1) * 2 + bj, b = (u.pm * BM) / SEQ;
                if (fr == 0 && fq == 0) __hip_atomic_fetch_max(kmax + ((b * 4 + head) * 2 + (wc >> 1)) * 2 + (wc & 1), __float_as_uint(s * 1.02f), __ATOMIC_RELAXED, __HIP_MEMORY_SCOPE_AGENT); }
        }
    }
};
struct EpiGLU {
    static constexpr bool PERM = true, AFTER_DRAIN = false;
    const bf16_t* Y; bf16_t* MIX; const float* bias; unsigned long long* ss;
    __device__ __forceinline__ void operator()(const f32x4 (&acc)[2][2][4][2], const Unit& u, int wr, int wc, int fr, int fq) const {
        const int row0 = u.pm * BM + wr * 64 + fr; const int colb = u.pn * BM + wc * 32 + 8 * fq;
        f32x4 bv[2][2];
#pragma unroll
        for (int bj = 0; bj < 2; ++bj) { bv[bj][0] = *(const PG8_GAS f32x4*)(bias + colb + bj * HALF); bv[bj][1] = *(const PG8_GAS f32x4*)(bias + colb + bj * HALF + 4); }
        u32x4 ya[4][2];
#pragma unroll
        for (int g = 0; g < 4; ++g)
#pragma unroll
            for (int bj = 0; bj < 2; ++bj) ya[g][bj] = *(const PG8_GAS u32x4*)(Y + (size_t)(row0 + g * 16) * 512 + colb + bj * HALF);
#pragma unroll
        for (int g = 0; g < 8; ++g) { const int ai = g >> 2, m = g & 3; const int row = row0 + ai * HALF + m * 16; float part = 0.f;
#pragma unroll
            for (int bj = 0; bj < 2; ++bj) { const u32x4 yw = ya[g & 3][bj];
                if (g < 4) ya[g][bj] = *(const PG8_GAS u32x4*)(Y + (size_t)(row + HALF) * 512 + colb + bj * HALF);
                const f32x4 y0 = {bf_lo(yw.x), bf_hi(yw.x), bf_lo(yw.y), bf_hi(yw.y)}, y1 = {bf_lo(yw.z), bf_hi(yw.z), bf_lo(yw.w), bf_hi(yw.w)};
                const f32x4 a0 = acc[ai][bj][m][0] + bv[bj][0], a1 = acc[ai][bj][m][1] + bv[bj][1]; f32x4 o0, o1;
#pragma unroll
                for (int e = 0; e < 4; ++e) { o0[e] = y0[e] * __builtin_amdgcn_rcpf(1.0f + __builtin_amdgcn_exp2f(-1.4426950408889634f * a0[e]));
                                              o1[e] = y1[e] * __builtin_amdgcn_rcpf(1.0f + __builtin_amdgcn_exp2f(-1.4426950408889634f * a1[e])); }
                part += sum4sq(o0) + sum4sq(o1);
                u32x4 w; w.x = cvt_pk_bf16(o0[0], o0[1]); w.y = cvt_pk_bf16(o0[2], o0[3]); w.z = cvt_pk_bf16(o1[0], o1[1]); w.w = cvt_pk_bf16(o1[2], o1[3]);
                *(PG8_GAS u32x4*)(MIX + (size_t)row * DM + colb + bj * HALF) = w; }
            part += __shfl_xor(part, 16); part += __shfl_xor(part, 32);
            if (fq == 0) ss_add(ss, row, part);
            asm volatile("" ::: "memory"); }
    }
};
template <bool IACC>
struct EpiResid {
    static constexpr bool PERM = true, AFTER_DRAIN = false;
    bf16_t* XB; const unsigned long long* ss_scale; float inv_n_scale; unsigned long long* ss_out; float descale;
    __device__ __forceinline__ void operator()(const f32x4 (&acc)[2][2][4][2], const Unit& u, int wr, int wc, int fr, int fq) const {
        const int row0 = u.pm * BM + wr * 64 + fr; const int colb = u.pn * BM + wc * 32 + 8 * fq;
        u32x4 xa[4][2];
#pragma unroll
        for (int g = 0; g < 4; ++g)
#pragma unroll
            for (int bj = 0; bj < 2; ++bj) xa[g][bj] = *(const PG8_GAS u32x4*)(XB + (size_t)(row0 + g * 16) * DM + colb + bj * HALF);
        float rs8[8]; rs8_from_ss(rs8, ss_scale, row0, inv_n_scale);
#pragma unroll
        for (int g = 0; g < 8; ++g) { const int ai = g >> 2, m = g & 3; const int row = row0 + ai * HALF + m * 16; const float rs = rs8[g]; float part = 0.f;
#pragma unroll
            for (int bj = 0; bj < 2; ++bj) { const u32x4 xw = xa[g & 3][bj];
                if (g < 4) xa[g][bj] = *(const PG8_GAS u32x4*)(XB + (size_t)(row + HALF) * DM + colb + bj * HALF);
                const f32x4 xo0 = {bf_lo(xw.x), bf_hi(xw.x), bf_lo(xw.y), bf_hi(xw.y)}, xo1 = {bf_lo(xw.z), bf_hi(xw.z), bf_lo(xw.w), bf_hi(xw.w)};
                const f32x4 xn0 = xo0 + (IACC ? i32acc(acc[ai][bj][m][0]) * descale : acc[ai][bj][m][0]) * rs, xn1 = xo1 + (IACC ? i32acc(acc[ai][bj][m][1]) * descale : acc[ai][bj][m][1]) * rs;
                part += sum4sq(xn0) + sum4sq(xn1);
                u32x4 w; w.x = cvt_pk_bf16(xn0[0], xn0[1]); w.y = cvt_pk_bf16(xn0[2], xn0[3]); w.z = cvt_pk_bf16(xn1[0], xn1[1]); w.w = cvt_pk_bf16(xn1[2], xn1[3]);
                *(PG8_GAS u32x4*)(XB + (size_t)row * DM + colb + bj * HALF) = w; }
            part += __shfl_xor(part, 16); part += __shfl_xor(part, 32);
            if (fq == 0) ss_add(ss_out, row, part);
            asm volatile("" ::: "memory"); }
    }
};
struct EpiGateUp {
    static constexpr bool PERM = true, AFTER_DRAIN = false;
    bf16_t* H; int ldh; const unsigned long long* ss;
    __device__ __forceinline__ void operator()(const f32x4 (&acc)[2][2][4][2], const Unit& u, int wr, int wc, int fr, int fq) const {
        const int row0 = u.pm * BM + wr * 64 + fr;
        float rs8[8]; rs8_from_ss(rs8, ss, row0, 1.0f / DM);
#pragma unroll
        for (int ai = 0; ai < 2; ++ai)
#pragma unroll
            for (int m = 0; m < 4; ++m) { const int row = row0 + ai * HALF + m * 16; const float rs = rs8[ai * 4 + m];
                f32x4 h[2];
#pragma unroll
                for (int n = 0; n < 2; ++n) { const f32x4 g = acc[ai][0][m][n] * rs, up = acc[ai][1][m][n] * rs;
#pragma unroll
                    for (int e = 0; e < 4; ++e) h[n][e] = g[e] * __builtin_amdgcn_rcpf(1.0f + __builtin_amdgcn_exp2f(-1.4426950408889634f * g[e])) * up[e]; }
                u32x4 w; w.x = cvt_pk_bf16(h[0][0], h[0][1]); w.y = cvt_pk_bf16(h[0][2], h[0][3]); w.z = cvt_pk_bf16(h[1][0], h[1][1]); w.w = cvt_pk_bf16(h[1][2], h[1][3]);
                *(PG8_GAS u32x4*)(H + (size_t)row * ldh + u.pn * HALF + wc * 32 + 8 * fq) = w;
                asm volatile("" ::: "memory"); }
    }
};
__device__ __forceinline__ unsigned pk4_i8(float a, float b, float c, float d) {
    unsigned w = 0; w = __builtin_amdgcn_cvt_pk_u8_f32(__builtin_rintf(a) + 128.f, 0, w); w = __builtin_amdgcn_cvt_pk_u8_f32(__builtin_rintf(b) + 128.f, 1, w);
    w = __builtin_amdgcn_cvt_pk_u8_f32(__builtin_rintf(c) + 128.f, 2, w); w = __builtin_amdgcn_cvt_pk_u8_f32(__builtin_rintf(d) + 128.f, 3, w); return w ^ 0x80808080u; }
__device__ __forceinline__ unsigned pk4_i8b(float a, float b, float c, float d) {
    unsigned w = 0; w = __builtin_amdgcn_cvt_pk_u8_f32(__builtin_rintf(a), 0, w); w = __builtin_amdgcn_cvt_pk_u8_f32(__builtin_rintf(b), 1, w);
    w = __builtin_amdgcn_cvt_pk_u8_f32(__builtin_rintf(c), 2, w); w = __builtin_amdgcn_cvt_pk_u8_f32(__builtin_rintf(d), 3, w); return w ^ 0x80808080u; }
template <bool OUT8>
struct EpiGateUp8 {
    static constexpr bool PERM = true, AFTER_DRAIN = false;
    unsigned char* H; int ldh; float descale, hscale;
    __device__ __forceinline__ void operator()(const f32x4 (&acc)[2][2][4][2], const Unit& u, int wr, int wc, int fr, int fq) const {
        const int row0 = u.pm * BM + wr * 64 + fr;
        const float C = descale * descale * hscale, ea = -1.4426950408889634f * descale, eb = -__builtin_amdgcn_logf(C), c0 = 1.0f / C;
#pragma unroll
        for (int ai = 0; ai < 2; ++ai)
#pragma unroll
            for (int m = 0; m < 4; ++m) { const int row = row0 + ai * HALF + m * 16;
                f32x4 h[2];
#pragma unroll
                for (int n = 0; n < 2; ++n) { const f32x4 g = i32acc(acc[ai][0][m][n]), up = i32acc(acc[ai][1][m][n]);
#pragma unroll
                    for (int e = 0; e < 4; ++e) { const float r = __builtin_amdgcn_rcpf(c0 + __builtin_amdgcn_exp2f(fmaf(g[e], ea, eb)));
                        h[n][e] = OUT8 ? fmaf(g[e] * up[e], r, 128.0f) : (g[e] * up[e]) * r; } }
                if constexpr (OUT8) { u32x2 w; w.x = pk4_i8b(h[0][0], h[0][1], h[0][2], h[0][3]); w.y = pk4_i8b(h[1][0], h[1][1], h[1][2], h[1][3]);
                    *(PG8_GAS u32x2*)(H + (size_t)row * ldh + u.pn * HALF + wc * 32 + 8 * fq) = w; }
                else { u32x4 w; w.x = cvt_pk_bf16(h[0][0], h[0][1]); w.y = cvt_pk_bf16(h[0][2], h[0][3]); w.z = cvt_pk_bf16(h[1][0], h[1][1]); w.w = cvt_pk_bf16(h[1][2], h[1][3]);
                    *(PG8_GAS u32x4*)((bf16_t*)H + (size_t)row * ldh + u.pn * HALF + wc * 32 + 8 * fq) = w; }
                asm volatile("" ::: "memory"); }
    }
};
template <bool IACC>
struct EpiStoreBf16 {
    static constexpr bool PERM = true, AFTER_DRAIN = false;
    bf16_t* O; int ldc; float scale;
    __device__ __forceinline__ void operator()(const f32x4 (&acc)[2][2][4][2], const Unit& u, int wr, int wc, int fr, int fq) const {
        const int row0 = u.pm * BM + wr * 64 + fr;
#pragma unroll
        for (int ai = 0; ai < 2; ++ai)
#pragma unroll
            for (int m = 0; m < 4; ++m) { bf16_t* rowp = O + (size_t)(row0 + ai * HALF + m * 16) * ldc + u.pn * BM + wc * 32 + 8 * fq;
#pragma unroll
                for (int bj = 0; bj < 2; ++bj) { const f32x4 v0 = (IACC ? i32acc(acc[ai][bj][m][0]) : acc[ai][bj][m][0]) * scale, v1 = (IACC ? i32acc(acc[ai][bj][m][1]) : acc[ai][bj][m][1]) * scale;
                    u32x4 w; w.x = cvt_pk_bf16(v0[0], v0[1]); w.y = cvt_pk_bf16(v0[2], v0[3]); w.z = cvt_pk_bf16(v1[0], v1[1]); w.w = cvt_pk_bf16(v1[2], v1[3]);
                    *(PG8_GAS u32x4*)(rowp + bj * HALF) = w; } }
    }
};

template <class Epi, class Sched, bool ALIGN_EPI = false, bool SP2 = false, int ESZ = 2  >
__device__ __forceinline__ void gemm_phase(PG8_LAS unsigned char* lds, const Gemm g, const Sched& S, const Epi& E) {
    int tid_ = threadIdx.x; asm volatile("" : "+v"(tid_));
    const int tid = tid_, wid = __builtin_amdgcn_readfirstlane(tid >> 6), lane = tid & 63, wr = wid >> 2, wc = wid & 3, fr = lane & 15, fq = lane >> 4;
    const int K = g.K * ESZ / 2  , nt = K / BK;
    unsigned voffA[2], voffB[2];
#pragma unroll
    for (int i = 0; i < 2; ++i) { int R, C; stage_rc(tid * 16 + i * 8192, R, C); const int Rb = Epi::PERM ? ((R & ~31) + perm32(R & 31)) : R;
        voffA[i] = (unsigned)(R * K + C) * 2u; voffB[i] = (unsigned)(Rb * K + C) * 2u; }
    const size_t kstep = (size_t)(BK * 2);
    const size_t hstep = (size_t)HALF * K * 2;
    const size_t tstep = 2 * hstep;
    const unsigned ldsw = (unsigned)wid * 1024u;
    const int aoff = lds_byte(wr * 64 + fr, fq * 8), boff = lds_byte(wc * 32 + fr, fq * 8);
#define PG8_SA(b, h) (((b) * 2 + (h)) * HTB)
#define PG8_SB(b, h) ((4 + (b) * 2 + (h)) * HTB)
#define PG8_STAGE(bufoff, gbase, voff) do { _Pragma("unroll") for (int _i = 0; _i < 2; ++_i) \
        __builtin_amdgcn_global_load_lds((const unsigned*)((const char*)(gbase) + (voff)[_i]), (PG8_LAS unsigned*)(lds + (bufoff) + ldsw + _i * 8192), 16, 0, 0); } while (0)
#define PG8_LDA(dst, b, h) do { _Pragma("unroll") for (int m = 0; m < 4; ++m) _Pragma("unroll") for (int k = 0; k < 2; ++k) dst[m][k] = *(const PG8_LAS bf16x8*)(lds + PG8_SA(b, h) + aoff + m * 2048 + k * 1024); } while (0)
#define PG8_LDB(dst, b, h) do { _Pragma("unroll") for (int n = 0; n < 2; ++n) _Pragma("unroll") for (int k = 0; k < 2; ++k) dst[n][k] = *(const PG8_LAS bf16x8*)(lds + PG8_SB(b, h) + boff + n * 2048 + k * 1024); } while (0)
#define PG8_MMA(ai, bj, At, Bt) do { __builtin_amdgcn_s_setprio(1); _Pragma("unroll") for (int m = 0; m < 4; ++m) _Pragma("unroll") for (int n = 0; n < 2; ++n) _Pragma("unroll") for (int k = 0; k < 2; ++k) { \
        if constexpr (ESZ == 2) acc[ai][bj][m][n] = __builtin_amdgcn_mfma_f32_16x16x32_bf16(Bt[n][k], At[m][k], acc[ai][bj][m][n], 0, 0, 0); \
        else acc[ai][bj][m][n] = __builtin_bit_cast(f32x4, __builtin_amdgcn_mfma_i32_16x16x64_i8(__builtin_bit_cast(v4i32, Bt[n][k]), __builtin_bit_cast(v4i32, At[m][k]), __builtin_bit_cast(v4i32, acc[ai][bj][m][n]), 0, 0, 0)); \
        } __builtin_amdgcn_s_setprio(0); } while (0)
#define PG8_WAIT_V(n) asm volatile("s_waitcnt vmcnt(" #n ")" ::: "memory")
#define PG8_WAIT_L(n) asm volatile("s_waitcnt lgkmcnt(" #n ")" ::: "memory")
#define PG8_BAR __builtin_amdgcn_s_barrier()
#define PG8_SCHED __builtin_amdgcn_sched_barrier(0)
    Unit cur, nxt; int ui = 0;
    if (!S.next(0, cur)) return;
    f32x4 acc[2][2][4][2];
#pragma unroll
    for (int a = 0; a < 2; ++a)
#pragma unroll
        for (int b = 0; b < 2; ++b)
#pragma unroll
            for (int m = 0; m < 4; ++m)
#pragma unroll
                for (int n = 0; n < 2; ++n) acc[a][b][m][n] = (f32x4){0.f, 0.f, 0.f, 0.f};
    bf16x8 At[4][2], B0[2][2], B1[2][2];
    const char* cA = (const char*)g.A + (size_t)cur.pm * tstep; const char* cB = (const char*)g.Bt + (size_t)cur.e * g.be + (size_t)cur.pn * tstep;
    S.a_ready(cur);
    if constexpr (SP2) {
        PG8_STAGE(PG8_SB(0, 0), cB, voffB); PG8_STAGE(PG8_SB(0, 1), cB + hstep, voffB); PG8_STAGE(PG8_SA(0, 0), cA, voffA); PG8_STAGE(PG8_SA(0, 1), cA + hstep, voffA);
        if (wr == 1) PG8_BAR;
        PG8_WAIT_V(2); PG8_BAR;
        PG8_STAGE(PG8_SB(1, 0), cB + kstep, voffB); PG8_STAGE(PG8_SA(1, 0), cA + kstep, voffA); PG8_STAGE(PG8_SB(1, 1), cB + hstep + kstep, voffB);
        PG8_WAIT_V(6); PG8_BAR;
    } else {
        PG8_STAGE(PG8_SB(0, 0), cB, voffB); PG8_STAGE(PG8_SA(0, 0), cA, voffA); PG8_STAGE(PG8_SB(0, 1), cB + hstep, voffB); PG8_STAGE(PG8_SA(0, 1), cA + hstep, voffA);
        if (wr == 1) PG8_BAR;
        PG8_WAIT_V(4); PG8_BAR;
        PG8_STAGE(PG8_SB(1, 0), cB + kstep, voffB); PG8_STAGE(PG8_SA(1, 0), cA + kstep, voffA); PG8_STAGE(PG8_SB(1, 1), cB + hstep + kstep, voffB);
        PG8_WAIT_V(6); PG8_BAR;
    }
    for (;;) {
        const bool has_next = S.next(ui + 1, nxt);
        const char* nA = has_next ? (const char*)g.A + (size_t)nxt.pm * tstep : cA; const char* nB = has_next ? (const char*)g.Bt + (size_t)nxt.e * g.be + (size_t)nxt.pn * tstep : cB;
#pragma unroll 1
        for (int t = 0; t < nt; t += 2) {
            const bool last = (t == nt - 2);
            const char* a1 = cA + (size_t)(t + 1) * kstep;
            const char* a2 = last ? nA : cA + (size_t)(t + 2) * kstep; const char* b2 = last ? nB : cB + (size_t)(t + 2) * kstep;
            const char* a3 = a2 + kstep; const char* b3 = b2 + kstep;
            if (last && has_next) S.a_ready(nxt);
            if constexpr (SP2) {
            PG8_LDB(B0, 0, 0); PG8_LDB(B1, 0, 1); PG8_SCHED; PG8_LDA(At, 0, 0); PG8_STAGE(PG8_SA(1, 1), a1 + hstep, voffA);
            PG8_WAIT_V(8); PG8_WAIT_L(0); PG8_BAR; PG8_MMA(0, 0, At, B0); PG8_MMA(0, 1, At, B1); PG8_BAR; PG8_SCHED;
            PG8_LDA(At, 0, 1); PG8_STAGE(PG8_SB(0, 0), b2, voffB); PG8_STAGE(PG8_SB(0, 1), b2 + hstep, voffB); PG8_STAGE(PG8_SA(0, 0), a2, voffA);
            PG8_WAIT_V(8); PG8_WAIT_L(0); PG8_BAR; PG8_MMA(1, 0, At, B0); PG8_MMA(1, 1, At, B1); PG8_BAR; PG8_SCHED;
            PG8_LDB(B0, 1, 0); PG8_LDB(B1, 1, 1); PG8_SCHED; PG8_LDA(At, 1, 0); PG8_STAGE(PG8_SA(0, 1), a2 + hstep, voffA);
            PG8_WAIT_V(8); PG8_WAIT_L(0); PG8_BAR; PG8_MMA(0, 0, At, B0); PG8_MMA(0, 1, At, B1); PG8_BAR; PG8_SCHED;
            PG8_LDA(At, 1, 1); PG8_STAGE(PG8_SB(1, 0), b3, voffB); PG8_STAGE(PG8_SB(1, 1), b3 + hstep, voffB); PG8_STAGE(PG8_SA(1, 0), a3, voffA);
            PG8_WAIT_V(8); PG8_WAIT_L(0); PG8_BAR; PG8_MMA(1, 0, At, B0); PG8_MMA(1, 1, At, B1); PG8_BAR; PG8_SCHED;
            } else {
            PG8_LDB(B0, 0, 0); PG8_SCHED; PG8_LDA(At, 0, 0); PG8_STAGE(PG8_SA(1, 1), a1 + hstep, voffA);
            PG8_WAIT_L(8); PG8_BAR; PG8_WAIT_L(0); PG8_MMA(0, 0, At, B0); PG8_BAR; PG8_SCHED;
            PG8_LDB(B1, 0, 1); PG8_STAGE(PG8_SB(0, 0), b2, voffB);
            PG8_BAR; PG8_WAIT_L(0); PG8_MMA(0, 1, At, B1); PG8_BAR;
            PG8_LDA(At, 0, 1); PG8_STAGE(PG8_SA(0, 0), a2, voffA);
            PG8_BAR; PG8_WAIT_L(0); PG8_MMA(1, 0, At, B0); PG8_BAR; PG8_SCHED;
            PG8_STAGE(PG8_SB(0, 1), b2 + hstep, voffB);
            PG8_WAIT_V(6); PG8_BAR; PG8_MMA(1, 1, At, B1); PG8_BAR;
            PG8_LDB(B0, 1, 0); PG8_SCHED; PG8_LDA(At, 1, 0); PG8_STAGE(PG8_SA(0, 1), a2 + hstep, voffA);
            PG8_WAIT_L(8); PG8_BAR; PG8_WAIT_L(0); PG8_MMA(0, 0, At, B0); PG8_BAR; PG8_SCHED;
            PG8_LDB(B1, 1, 1); PG8_STAGE(PG8_SB(1, 0), b3, voffB);
            PG8_BAR; PG8_WAIT_L(0); PG8_MMA(0, 1, At, B1); PG8_BAR;
            PG8_LDA(At, 1, 1); PG8_STAGE(PG8_SA(1, 0), a3, voffA);
            PG8_BAR; PG8_WAIT_L(0); PG8_MMA(1, 0, At, B0); PG8_BAR; PG8_SCHED;
            PG8_STAGE(PG8_SB(1, 1), b3 + hstep, voffB);
            PG8_WAIT_V(6); PG8_BAR; PG8_MMA(1, 1, At, B1); PG8_BAR;
            }
        }
        if constexpr (ALIGN_EPI) { if (wr == 0) PG8_BAR; }
        if constexpr (!Epi::AFTER_DRAIN) { E(acc, cur, wr, wc, fr, fq); S.done(cur); }
        if (!has_next) break;
#pragma unroll
        for (int a = 0; a < 2; ++a)
#pragma unroll
            for (int b = 0; b < 2; ++b)
#pragma unroll
                for (int m = 0; m < 4; ++m)
#pragma unroll
                    for (int n = 0; n < 2; ++n) acc[a][b][m][n] = (f32x4){0.f, 0.f, 0.f, 0.f};
        cur = nxt; cA = nA; cB = nB; ++ui;
        if constexpr (ALIGN_EPI) { if (wr == 1) PG8_BAR; }
    }
    PG8_WAIT_V(0);
    if constexpr (!ALIGN_EPI) { if (wr == 0) PG8_BAR; }
    PG8_BAR;
    if constexpr (Epi::AFTER_DRAIN) { E.fused(acc, cur, wr, wc, fr, fq, lds, wid, lane); S.done(cur); }
#undef PG8_SA
#undef PG8_SB
#undef PG8_STAGE
#undef PG8_LDA
#undef PG8_LDB
#undef PG8_MMA
#undef PG8_WAIT_V
#undef PG8_WAIT_L
#undef PG8_BAR
#undef PG8_SCHED
}
}


namespace att {
using bf16 = unsigned short;
using bf16x8 = __attribute__((ext_vector_type(8))) short;
using s16x4  = __attribute__((ext_vector_type(4))) short;
using f32x16 = __attribute__((ext_vector_type(16))) float;
using u32x4  = __attribute__((ext_vector_type(4))) unsigned;
constexpr int NW = 8, QBLK = 32, KVBLK = 64, LDQ = 512;
constexpr int SHM_V = KVBLK * 128 * 2, SHM_K = KVBLK * 64 * 2, SHM_ATTN = 2 * SHM_V + 2 * SHM_K + NW * 64 * 4;
constexpr float THR2 = 8.f;
#define ATT_KSWZ(row, colB) ((row) * 128 + ((colB) ^ ((((row) >> 1) & 7) << 4)))
#define ATT_SBAR() __builtin_amdgcn_sched_barrier(0)
__device__ __forceinline__ int crow(int r, int hi) { return (r & 3) + 8 * (r >> 2) + 4 * hi; }
__device__ __forceinline__ unsigned cvtpk(float lo, float hi) { unsigned r; asm volatile("v_cvt_pk_bf16_f32 %0, %1, %2" : "=v"(r) : "v"(lo), "v"(hi)); return r; }

typedef __attribute__((address_space(3))) char lchar;
typedef __attribute__((address_space(3))) float lfloat;
__device__ __forceinline__ void qkt(f32x16& p0, f32x16& p1, const lchar* Ks, const bf16x8* qr, int r32, int hi, const f32x16 seed = f32x16{}) {
  bf16x8 kf[8];
#pragma unroll
  for (int d0 = 0; d0 < 4; ++d0) { const int cb = (d0 * 16 + hi * 8) * 2;
    kf[2 * d0] = *(const __attribute__((address_space(3))) bf16x8*)(Ks + ATT_KSWZ(r32, cb));
    kf[2 * d0 + 1] = *(const __attribute__((address_space(3))) bf16x8*)(Ks + ATT_KSWZ(32 + r32, cb)); }
  asm volatile("s_waitcnt lgkmcnt(0)" ::: "memory"); ATT_SBAR();
  p0 = seed; p1 = seed;
#pragma unroll
  for (int d0 = 0; d0 < 4; ++d0) {
    p0 = __builtin_amdgcn_mfma_f32_32x32x16_bf16(kf[2 * d0], qr[d0], p0, 0, 0, 0);
    p1 = __builtin_amdgcn_mfma_f32_32x32x16_bf16(kf[2 * d0 + 1], qr[d0], p1, 0, 0, 0); }
}
__device__ __forceinline__ int v_st(int k, int c) { const int kk = (k & ~0xC) | ((k & 4) << 1) | ((k & 8) >> 1); return ((kk >> 3) * 4 + (c >> 5)) * 512 + ((kk & 7) * 32 + (c & 31)) * 2; }
__device__ __forceinline__ int v_rd_base(int lane) { return ((lane & 3) << 3) | (((lane >> 2) & 3) << 6) | (((lane >> 4) & 1) << 5) | (((lane >> 5) & 1) << 8); }
constexpr int v_rd_off(int d0, int ks, int half) { return d0 * 512 + ks * 4096 + half * 2048; }
template <int OFF> __device__ __forceinline__ s16x4 tr_read(int vb) {
  s16x4 r; asm volatile("ds_read_b64_tr_b16 %0, %1 offset:%2" : "=&v"(r) : "v"(vb), "i"(OFF) : "memory"); return r;
}
template <int D0> __device__ __forceinline__ void pv_one(f32x16& od, int vb, bf16x8 pa0, bf16x8 pa1, bf16x8 pa2, bf16x8 pa3) {
  const s16x4 l0 = tr_read<v_rd_off(D0, 0, 0)>(vb), h0 = tr_read<v_rd_off(D0, 0, 1)>(vb), l1 = tr_read<v_rd_off(D0, 1, 0)>(vb), h1 = tr_read<v_rd_off(D0, 1, 1)>(vb);
  const s16x4 l2 = tr_read<v_rd_off(D0, 2, 0)>(vb), h2 = tr_read<v_rd_off(D0, 2, 1)>(vb), l3 = tr_read<v_rd_off(D0, 3, 0)>(vb), h3 = tr_read<v_rd_off(D0, 3, 1)>(vb);
  asm volatile("s_waitcnt lgkmcnt(0)" ::: "memory"); ATT_SBAR();
#define ATT_PK(L, H) (bf16x8){L[0], L[1], L[2], L[3], H[0], H[1], H[2], H[3]}
  od = __builtin_amdgcn_mfma_f32_32x32x16_bf16(pa0, ATT_PK(l0, h0), od, 0, 0, 0);
  od = __builtin_amdgcn_mfma_f32_32x32x16_bf16(pa1, ATT_PK(l1, h1), od, 0, 0, 0);
  od = __builtin_amdgcn_mfma_f32_32x32x16_bf16(pa2, ATT_PK(l2, h2), od, 0, 0, 0);
  od = __builtin_amdgcn_mfma_f32_32x32x16_bf16(pa3, ATT_PK(l3, h3), od, 0, 0, 0);
#undef ATT_PK
}
__device__ __forceinline__ void pv_d0(f32x16* o, int vb, bf16x8 pa0, bf16x8 pa1, bf16x8 pa2, bf16x8 pa3) {
  pv_one<0>(o[0], vb, pa0, pa1, pa2, pa3); pv_one<1>(o[1], vb, pa0, pa1, pa2, pa3); pv_one<2>(o[2], vb, pa0, pa1, pa2, pa3); pv_one<3>(o[3], vb, pa0, pa1, pa2, pa3);
}

typedef __attribute__((address_space(1))) const bf16x8 gbf16x8;
struct Stage { bf16x8 v0, v1, k0; };
struct PassCtx {
  const bf16* Kh; const bf16* Vh; long vl_off, vr_off; lchar* V_lds; lchar* K_lds;
  int sr, sc, vst0, vst1, kr, kcB, kst, vb0, qpos, td0, td1, r32, hi, t_hi;
  float slope2, m_i, g1, g8, g32, i1, i8, i32, lfL, lfR;
};
__device__ __forceinline__ void st_load(Stage& s, const PassCtx& c, int t) {
  const long vo = t < c.td0 ? c.vl_off : c.vr_off; const int k0 = t * KVBLK;
  s.v0 = *(gbf16x8*)(c.Vh + vo + (long)(k0 + c.sr) * LDQ + c.sc); s.v1 = *(gbf16x8*)(c.Vh + vo + (long)(k0 + 32 + c.sr) * LDQ + c.sc);
  s.k0 = *(gbf16x8*)(c.Kh + (long)(k0 + c.kr) * LDQ + (c.kcB >> 1));
}
__device__ __forceinline__ void st_write(const Stage& s, const PassCtx& c, int b) {
  *(__attribute__((address_space(3))) bf16x8*)(c.V_lds + b * SHM_V + c.vst0) = s.v0; *(__attribute__((address_space(3))) bf16x8*)(c.V_lds + b * SHM_V + c.vst1) = s.v1;
  *(__attribute__((address_space(3))) bf16x8*)(c.K_lds + b * SHM_K + c.kst) = s.k0;
}
#define ATT_PK4(P, BASE, OUT) do { unsigned a0 = cvtpk(P[BASE + 0], P[BASE + 1]), a1 = cvtpk(P[BASE + 2], P[BASE + 3]);   \
    unsigned b0 = cvtpk(P[BASE + 4], P[BASE + 5]), b1 = cvtpk(P[BASE + 6], P[BASE + 7]);                              \
    auto r0 = __builtin_amdgcn_permlane32_swap(a0, b0, false, false); auto r1 = __builtin_amdgcn_permlane32_swap(a1, b1, false, false); \
    u32x4 w = {r0[0], r1[0], r0[1], r1[1]}; OUT = *reinterpret_cast<bf16x8*>(&w); } while (0)
__device__ __forceinline__ void att_rowsum(float& l_reg, const f32x16& p0, const f32x16& p1, float h1, float h8, float h32, float lf) {
  float u0, u1;
  { float t0 = fmaf(fmaf(fmaf(p0[3], h1, p0[2]), h1, p0[1]), h1, p0[0]), t1 = fmaf(fmaf(fmaf(p0[7], h1, p0[6]), h1, p0[5]), h1, p0[4]);
    float t2 = fmaf(fmaf(fmaf(p0[11], h1, p0[10]), h1, p0[9]), h1, p0[8]), t3 = fmaf(fmaf(fmaf(p0[15], h1, p0[14]), h1, p0[13]), h1, p0[12]);
    u0 = fmaf(fmaf(fmaf(t3, h8, t2), h8, t1), h8, t0); }
  { float t0 = fmaf(fmaf(fmaf(p1[3], h1, p1[2]), h1, p1[1]), h1, p1[0]), t1 = fmaf(fmaf(fmaf(p1[7], h1, p1[6]), h1, p1[5]), h1, p1[4]);
    float t2 = fmaf(fmaf(fmaf(p1[11], h1, p1[10]), h1, p1[9]), h1, p1[8]), t3 = fmaf(fmaf(fmaf(p1[15], h1, p1[14]), h1, p1[13]), h1, p1[12]);
    u1 = fmaf(fmaf(fmaf(t3, h8, t2), h8, t1), h8, t0); }
  l_reg = fmaf(fmaf(u1, h32, u0), lf, l_reg);
}
template <int B>
__device__ __forceinline__ void attn_tile(int j, int jn, const PassCtx& c, const bf16x8 (&qr)[4], f32x16 (&o)[4], float& l_reg, Stage& ld, const Stage& wr) {
  st_load(ld, c, jn);
  f32x16 p0, p1;
  float h1, h8, h32, lf;
  float cc;
  if (j < c.td0) {
    cc = -c.slope2 * (float)(c.qpos - j * KVBLK - 63) - c.m_i; h1 = c.g1; h8 = c.g8; h32 = c.g32; lf = c.lfL;
  } else {
    cc = -c.slope2 * (float)(j * KVBLK - c.qpos) - c.m_i; h1 = c.i1; h8 = c.i8; h32 = c.i32; lf = c.lfR;
  }
  { f32x16 seed;
#pragma unroll
    for (int r = 0; r < 16; ++r) seed[r] = cc;
    qkt(p0, p1, c.K_lds + B * SHM_K, qr, c.r32, c.hi, seed); }
#pragma unroll
  for (int r = 0; r < 16; ++r) { p0[r] = __builtin_amdgcn_exp2f(p0[r]); p1[r] = __builtin_amdgcn_exp2f(p1[r]); }
  att_rowsum(l_reg, p0, p1, h1, h8, h32, lf);
  bf16x8 pa0, pa1, pa2, pa3;
  ATT_PK4(p0, 0, pa0); ATT_PK4(p0, 8, pa1); ATT_PK4(p1, 0, pa2); ATT_PK4(p1, 8, pa3);
  ATT_SBAR();
  pv_d0(o, c.vb0 + B * SHM_V, pa0, pa1, pa2, pa3);
  asm volatile("s_waitcnt lgkmcnt(0)\n\ts_barrier" ::: "memory");
  st_write(wr, c, B);
}
__device__ __forceinline__ void attn_diag_tile(int t, const PassCtx& c, const bf16x8 (&qr)[4], f32x16 (&o)[4], float& l_reg, const lchar* Kd, int vbd, const f32x16& sd0, const f32x16& sd1) {
  f32x16 p0, p1;
  { bf16x8 kf[8];
#pragma unroll
    for (int d0 = 0; d0 < 4; ++d0) { const int cb = (d0 * 16 + c.hi * 8) * 2;
      kf[2 * d0] = *(const __attribute__((address_space(3))) bf16x8*)(Kd + ATT_KSWZ(c.r32, cb));
      kf[2 * d0 + 1] = *(const __attribute__((address_space(3))) bf16x8*)(Kd + ATT_KSWZ(32 + c.r32, cb)); }
    asm volatile("s_waitcnt lgkmcnt(0)" ::: "memory"); ATT_SBAR();
    p0 = sd0; p1 = sd1;
#pragma unroll
    for (int d0 = 0; d0 < 4; ++d0) {
      p0 = __builtin_amdgcn_mfma_f32_32x32x16_bf16(kf[2 * d0], qr[d0], p0, 0, 0, 0);
      p1 = __builtin_amdgcn_mfma_f32_32x32x16_bf16(kf[2 * d0 + 1], qr[d0], p1, 0, 0, 0); } }
  float dq = (float)(c.qpos - (c.td0 + t) * KVBLK - 4 * c.hi); asm volatile("" : "+v"(dq));
#pragma unroll
  for (int r = 0; r < 16; ++r) { const float cc = (float)((r & 3) + 8 * (r >> 2));
    p0[r] = __builtin_amdgcn_exp2f(fmaf(-c.slope2, fabsf(dq - cc), p0[r])); p1[r] = __builtin_amdgcn_exp2f(fmaf(-c.slope2, fabsf(dq - (cc + 32.f)), p1[r])); }
  att_rowsum(l_reg, p0, p1, c.i1, c.i8, c.i32, c.lfR);
  bf16x8 pa0, pa1, pa2, pa3;
  ATT_PK4(p0, 0, pa0); ATT_PK4(p0, 8, pa1); ATT_PK4(p1, 0, pa2); ATT_PK4(p1, 8, pa3);
  ATT_SBAR();
  pv_d0(o, vbd, pa0, pa1, pa2, pa3);
}
__device__ __forceinline__ void attn_pass(const bf16* Qw, const bf16* Kh, const bf16* Vh, long vl_off, long vr_off, int qb, float slope2, float k2max  , lchar* lds, f32x16 (&o)[4], float& l_out) {
  int tid_ = threadIdx.x; asm volatile("" : "+v"(tid_));
  const int tid = tid_, wid = tid >> 6, lane = tid & 63;
  PassCtx c;
  c.r32 = lane & 31; c.hi = lane >> 5; c.Kh = Kh; c.Vh = Vh; c.vl_off = vl_off; c.vr_off = vr_off; c.V_lds = lds; c.K_lds = lds + 2 * SHM_V; c.slope2 = slope2;
  c.sr = tid >> 4; c.sc = (tid & 15) * 8; c.vst0 = v_st(c.sr, c.sc); c.vst1 = v_st(32 + c.sr, c.sc);
  c.kr = tid >> 3; c.kcB = (tid & 7) * 16; c.kst = ATT_KSWZ(c.kr, c.kcB);
  c.vb0 = (int)(unsigned)(uintptr_t)c.V_lds + v_rd_base(lane);
  c.qpos = qb * 256 + wid * QBLK + c.r32; c.td0 = 4 * qb; c.td1 = 4 * qb + 3;
  c.g1 = __builtin_amdgcn_exp2f(slope2); c.g8 = __builtin_amdgcn_exp2f(8.f * slope2); c.g32 = __builtin_amdgcn_exp2f(32.f * slope2);
  c.i1 = __builtin_amdgcn_exp2f(-slope2); c.i8 = __builtin_amdgcn_exp2f(-8.f * slope2); c.i32 = __builtin_amdgcn_exp2f(-32.f * slope2);
  c.lfL = __builtin_amdgcn_exp2f(slope2 * (float)(4 * c.hi - 63)); c.lfR = __builtin_amdgcn_exp2f(-slope2 * (float)(4 * c.hi));
  float l_reg = 0;
#pragma unroll
  for (int d = 0; d < 4; ++d) o[d] = f32x16{};
  bf16x8 qr[4];
#pragma unroll
  for (int d0 = 0; d0 < 4; ++d0) qr[d0] = *(gbf16x8*)(Qw + (long)c.r32 * LDQ + d0 * 16 + c.hi * 8);
  float m_i, ex;
  { float s = 0.f;
#pragma unroll
    for (int d0 = 0; d0 < 4; ++d0) { const u32x4 w = __builtin_bit_cast(u32x4, qr[d0]);
      const float a0 = __uint_as_float(w.x << 16), a1 = __uint_as_float(w.x & 0xffff0000u), a2 = __uint_as_float(w.y << 16), a3 = __uint_as_float(w.y & 0xffff0000u);
      const float a4 = __uint_as_float(w.z << 16), a5 = __uint_as_float(w.z & 0xffff0000u), a6 = __uint_as_float(w.w << 16), a7 = __uint_as_float(w.w & 0xffff0000u);
      s += (a0 * a0 + a1 * a1) + (a2 * a2 + a3 * a3) + (a4 * a4 + a5 * a5) + (a6 * a6 + a7 * a7); }
    { auto rr = __builtin_amdgcn_permlane32_swap(__float_as_uint(s), __float_as_uint(s), false, false); s = __uint_as_float(rr[0]) + __uint_as_float(rr[1]); }
    const float m_bound = sqrtf(s * k2max) * 1.01f + 0.01f; m_i = fminf(m_bound, 64.0f); ex = m_bound - m_i; }
  c.m_i = m_i;
  int t_lo, t_hi;
  { lchar* Kd = lds + 4 * SHM_V; lchar* Vd = lds;
    { const bf16* kp = Kh + (long)(c.td0 * KVBLK + c.kr) * LDQ + (c.kcB >> 1); const bf16* vp = Vh + vr_off + (long)(c.td0 * KVBLK + c.sr) * LDQ + c.sc;
      bf16x8 k4[4], v4a[4], v4b[4];
#pragma unroll
      for (int t = 0; t < 4; ++t) { k4[t] = *(gbf16x8*)(kp + (long)t * KVBLK * LDQ); v4a[t] = *(gbf16x8*)(vp + (long)t * KVBLK * LDQ); v4b[t] = *(gbf16x8*)(vp + (long)(t * KVBLK + 32) * LDQ); }
#pragma unroll
      for (int t = 0; t < 4; ++t) { *(__attribute__((address_space(3))) bf16x8*)(Kd + t * SHM_K + c.kst) = k4[t];
        *(__attribute__((address_space(3))) bf16x8*)(Vd + t * SHM_V + c.vst0) = v4a[t]; *(__attribute__((address_space(3))) bf16x8*)(Vd + t * SHM_V + c.vst1) = v4b[t]; } }
    asm volatile("s_waitcnt lgkmcnt(0)" ::: "memory"); __syncthreads();
    { f32x16 sd0, sd1;
#pragma unroll
      for (int r = 0; r < 16; ++r) { sd0[r] = fmaf(c.slope2, (float)((r & 3) + 8 * (r >> 2) + 4 * c.hi), -c.m_i); sd1[r] = fmaf(c.slope2, (float)((r & 3) + 8 * (r >> 2) + 4 * c.hi + 32), -c.m_i); }
#pragma unroll 1
      for (int t = 0; t < 4; ++t) attn_diag_tile(t, c, qr, o, l_reg, Kd + t * SHM_K, c.vb0 + t * SHM_V, sd0, sd1); }
    float lp;
    { auto rr = __builtin_amdgcn_permlane32_swap(__float_as_uint(l_reg), __float_as_uint(l_reg), false, false); lp = (__uint_as_float(rr[0]) + __uint_as_float(rr[1])) * __builtin_amdgcn_exp2f(-ex); }
#pragma unroll
    for (int o_ = 1; o_ < 32; o_ <<= 1) lp = fminf(lp, __shfl_xor(lp, o_));
    lfloat* wsred = (lfloat*)(lds + 4 * SHM_V + 4 * SHM_K);
    if (lane == 0) wsred[wid] = lp;
    asm volatile("s_waitcnt lgkmcnt(0)" ::: "memory"); __syncthreads();
    float lmin = wsred[0];
#pragma unroll
    for (int w = 1; w < 8; ++w) lmin = fminf(lmin, wsred[w]);
    lmin = __uint_as_float(__builtin_amdgcn_readfirstlane(__float_as_uint(lmin)));
    const float dist = (24.0f - __builtin_amdgcn_logf(fmaxf(lmin, 1e-37f))) / slope2;
    const int D = dist >= 8192.f ? 8192 : (int)dist + 1, q0 = qb * 256;
    const int klo = q0 - D, khi = q0 + 255 + D; t_lo = klo <= 0 ? 0 : (klo >> 6); t_hi = khi >= SEQ - 1 ? (SEQ / 64 - 1) : (khi >> 6); }
  const int nl = c.td0 - t_lo, n = nl + (t_hi - c.td1);
  c.t_hi = t_hi;
  if (n > 0) {
#define ATT_TILE_OF(s_) ({ int s__ = (s_) < n - 1 ? (s_) : n - 1; s__ < nl ? t_lo + s__ : c.td1 + 1 + (s__ - nl); })
    Stage sA, sB;
    st_load(sA, c, ATT_TILE_OF(0)); st_write(sA, c, 0); st_load(sB, c, ATT_TILE_OF(1)); st_write(sB, c, 1);
    st_load(sA, c, ATT_TILE_OF(2));
    __syncthreads();
#pragma unroll 1
    for (int s = 0; s < n; s += 2) {
      attn_tile<0>(ATT_TILE_OF(s), ATT_TILE_OF(s + 3), c, qr, o, l_reg, sB, sA);
      if (s + 1 < n) attn_tile<1>(ATT_TILE_OF(s + 1), ATT_TILE_OF(s + 4), c, qr, o, l_reg, sA, sB);
    }
#undef ATT_TILE_OF
  }
  { auto rr = __builtin_amdgcn_permlane32_swap(__float_as_uint(l_reg), __float_as_uint(l_reg), false, false); l_out = __uint_as_float(rr[0]) + __uint_as_float(rr[1]); }
  __syncthreads();
}
#undef ATT_PK4
}


#define GAS __attribute__((address_space(1)))
#define LAS __attribute__((address_space(3)))
typedef unsigned short bf16;
typedef unsigned v4u __attribute__((ext_vector_type(4)));
typedef float f32x4 __attribute__((ext_vector_type(4)));
typedef short bf16x8 __attribute__((ext_vector_type(8)));
typedef GAS unsigned gu32;
typedef GAS unsigned long long gu64;
#define RLX_AGENT __ATOMIC_RELAXED, __HIP_MEMORY_SCOPE_AGENT
#define LDS_WAIT() asm volatile("s_waitcnt lgkmcnt(0)" ::: "memory")
#define VM_WAIT() asm volatile("s_waitcnt vmcnt(0)" ::: "memory")
__device__ __forceinline__ unsigned long long rt() { return __builtin_amdgcn_s_memrealtime(); }
__device__ __forceinline__ unsigned f2bf(float f) { unsigned u = __builtin_bit_cast(unsigned, f); return (u + 0x7fffu + ((u >> 16) & 1u)) >> 16; }
__device__ __forceinline__ unsigned pk2(float lo, float hi) { return f2bf(lo) | (f2bf(hi) << 16); }

#define XB_TMO      128
#define XB_XCNT(j)  (256  + 64 * (j))
#define XB_XSUB(j)  (1280 + 64 * (j))
#define XB_XGEN(j)  (2304 + 64 * (j))
#define XB_TOP      3328
#define XB_TOPGEN   3392
#define XCD_BAR_WORDS 3456
#define XB_SPIN_CAP (1u << 18)

__device__ __forceinline__ unsigned xb_ld(unsigned* p)              { return __hip_atomic_load(p, __ATOMIC_RELAXED, __HIP_MEMORY_SCOPE_AGENT); }
__device__ __forceinline__ unsigned xb_add(unsigned* p, unsigned v) { return __hip_atomic_fetch_add(p, v, __ATOMIC_RELAXED, __HIP_MEMORY_SCOPE_AGENT); }
__device__ __forceinline__ unsigned xb_xcc_id() { return (unsigned)__builtin_amdgcn_s_getreg((3 << 11) | 20) & 0xFu; }
#define XB_SPIN(cond, bar) do { unsigned _sp = 0; while (cond) { __builtin_amdgcn_s_sleep(1); \
    if ((++_sp & 255u) == 0u) { if (xb_ld(&(bar)[XB_TMO])) break; if (_sp > XB_SPIN_CAP) { atomicAdd(&(bar)[XB_TMO], 1u); break; } } } } while (0)

struct XcdBarrier {
    unsigned* bar; unsigned x;
    volatile LAS unsigned* st;
};

__device__ __forceinline__ XcdBarrier xcd_barrier_post(unsigned* bar, volatile LAS unsigned* st) {
    XcdBarrier b; b.bar = bar; b.x = xb_xcc_id(); b.st = st;
    if (threadIdx.x == 0) (void)xb_add(&bar[XB_XCNT(b.x)], 1u);
    return b;
}
__device__ __forceinline__ void xcd_barrier_complete(unsigned* bar, unsigned x, unsigned& nloc, unsigned& nx) {
    const unsigned G = gridDim.x * gridDim.y * gridDim.z;
    unsigned sum, cnt, mine, sp = 0u;
    for (;;) {
        sum = 0u; cnt = 0u; mine = 0u;
#pragma unroll
        for (unsigned j = 0; j < 16; ++j) { const unsigned c = xb_ld(&bar[XB_XCNT(j)]); sum += c; cnt += (c > 0u) ? 1u : 0u; mine = (j == x) ? c : mine; }
        if (sum == G) break;
        __builtin_amdgcn_s_sleep(1);
        if ((++sp & 255u) == 0u) { if (xb_ld(&bar[XB_TMO])) break; if (sp > XB_SPIN_CAP) { atomicAdd(&bar[XB_TMO], 1u); break; } }
    }
    nloc = mine > 0u ? mine : 1u; nx = cnt > 0u ? cnt : 1u;
}

__device__ __forceinline__ void xcd_barrier(const XcdBarrier& b) {
    asm volatile("s_waitcnt vmcnt(0)" ::: "memory");
    __syncthreads();
    if (threadIdx.x == 0) {
        unsigned* bar = b.bar;
        __builtin_amdgcn_s_waitcnt(0);
        unsigned nloc = b.st[0], nx = b.st[1];
        if (nloc == 0u) { xcd_barrier_complete(bar, b.x, nloc, nx); b.st[0] = nloc; b.st[1] = nx; }
        const unsigned old = xb_add(&bar[XB_XSUB(b.x)], 1u);
        const unsigned gen = old / nloc;
        if (old + 1u == (gen + 1u) * nloc) {
            __builtin_amdgcn_fence(__ATOMIC_RELEASE, "agent");
            asm volatile("s_waitcnt vmcnt(0)" ::: "memory");
            const unsigned og = xb_add(&bar[XB_TOP], 1u);
            const unsigned tg = og / nx;
            if (og + 1u == (tg + 1u) * nx) xb_add(&bar[XB_TOPGEN], 1u);
            else XB_SPIN(xb_ld(&bar[XB_TOPGEN]) == tg, bar);
            __builtin_amdgcn_fence(__ATOMIC_ACQUIRE, "agent");
            xb_add(&bar[XB_XGEN(b.x)], 1u);
            asm volatile("s_waitcnt vmcnt(0)" ::: "memory");
        } else {
            XB_SPIN(xb_ld(&bar[XB_XGEN(b.x)]) == gen, bar);
            __builtin_amdgcn_fence(__ATOMIC_ACQUIRE, "agent");
            asm volatile("s_waitcnt vmcnt(0)" ::: "memory");
        }
    }
    __syncthreads();
}

constexpr size_t MiB = 1u << 20;
constexpr size_t WS_CTL = 0;
constexpr size_t WS_SS = 1 * MiB;
constexpr size_t ZERO_BYTES = 4 * MiB;
constexpr size_t WS_ROUTE = 4 * MiB;
constexpr size_t WS_WR = 5 * MiB;
constexpr size_t WS_WIN = 6 * MiB;
constexpr size_t WS_WGLU = WS_WIN + 16 * MiB;
constexpr size_t WS_WOUT = WS_WGLU + 2 * MiB;
constexpr size_t WS_DGU = WS_WOUT + 8 * MiB;
constexpr size_t WS_DDN = WS_DGU + 22 * MiB;
constexpr size_t WS_MGU = WS_DDN + 11 * MiB;
constexpr size_t WS_MDN = WS_MGU + 224 * MiB;
constexpr size_t WS_SSMT = WS_MDN + 112 * MiB;
constexpr size_t WS_XB = WS_SSMT + 41 * MiB;
constexpr size_t WS_B = WS_XB + 64 * MiB;
static_assert(WS_B == 506 * MiB, "map");
constexpr size_t WS_UG = WS_B, WS_Q = WS_B + 32 * MiB, WS_K = WS_B + 64 * MiB, WS_V = WS_B + 96 * MiB, WS_Y = WS_B + 128 * MiB, WS_MIX = WS_B + 160 * MiB;
constexpr size_t WS_ATMP = WS_B + 224 * MiB;
constexpr size_t WS_VL = WS_B + 288 * MiB, WS_VR = WS_B + 320 * MiB;
constexpr size_t WS_SSMX = WS_ATMP;
constexpr size_t WS_HD = WS_B;
constexpr size_t WS_XQ = WS_B + 192 * MiB;
constexpr size_t WS_XG = WS_B;
constexpr int MOE_TILES_MAX = (2 * M) / 256 + NEXP;
constexpr int MOE_ROWS = MOE_TILES_MAX * 256;
constexpr size_t WS_HM = WS_XG + 132 * MiB;
constexpr int HM_TILES = MOE_TILES_MAX;
constexpr size_t WS_END = WS_HM + (size_t)HM_TILES * 256 * DFE;
static_assert(WS_END <= 896 * MiB && WS_VR + 32 * MiB <= 896 * MiB && 2 * HM_TILES >= MOE_TILES_MAX, "d_ws budget");
constexpr int CW_BAR = 4096;
constexpr int CW_KMAX = 20480;
constexpr int CW_ATTQ = 24576;
constexpr int CW_ROUTE = 16384;
__host__ __device__ constexpr int SS_MIXN(int L) { return L; }
__host__ __device__ constexpr int SS_GLU(int L) { return 4 + L; }
__host__ __device__ constexpr int SS_FFN(int L) { return 8 + L; }

constexpr int RING_OFF = 0, RING_BYTES = 131072;
constexpr int LDSCTL_OFF = RING_BYTES, MISC_OFF = LDSCTL_OFF + 320;
constexpr int LDS_BYTES = 147456;
constexpr int NWAVES = 8;

struct Frame {
    LAS unsigned char* lds;
    volatile LAS unsigned* MISC;
    gu32* ctl;
    int tid, lane, wave;
    int vcu, G;
    float* out; unsigned char* ws;
};
struct Args { const float* in[30]; float* out; unsigned char* ws; int ph_lo, ph_hi; };
constexpr int ARGT_OFF = LDSCTL_OFF + 1024;
extern __shared__ __attribute__((aligned(16))) unsigned char g_lds[];
__device__ __forceinline__ unsigned long long argt(int k) {
    const LAS unsigned* t = (const LAS unsigned*)((LAS unsigned char*)g_lds + ARGT_OFF) + 2 * k;
    const unsigned lo = __builtin_amdgcn_readfirstlane(t[0]), hi = __builtin_amdgcn_readfirstlane(t[1]);
    return ((unsigned long long)hi << 32) | lo;
}
typedef float f32x2v __attribute__((ext_vector_type(2)));
struct ArgView { __device__ __forceinline__ const float* operator[](int k) const { return (const float*)argt(k); } };
__device__ __forceinline__ Frame make_frame() {
    Frame F;
    F.lds = (LAS unsigned char*)g_lds;
    F.MISC = (volatile LAS unsigned*)(F.lds + MISC_OFF);
    { int t_ = threadIdx.x; asm volatile("" : "+v"(t_)); F.tid = t_; } F.lane = F.tid & 63; F.wave = __builtin_amdgcn_readfirstlane(F.tid >> 6);
    F.G = gridDim.x; { const int bx = blockIdx.x; F.vcu = (F.G % 8 == 0) ? (bx % 8) * (F.G / 8) + bx / 8 : bx; }
    F.out = (float*)argt(30); F.ws = (unsigned char*)argt(31); F.ctl = (gu32*)(F.ws + WS_CTL);
    return F;
}
__device__ __forceinline__ float wave_sum(float v) {
#pragma unroll
    for (int o = 1; o < 64; o <<= 1) v += __shfl_xor(v, o);
    return v;
}
__device__ __forceinline__ float lambda_init(int L) { return 0.8f - 0.6f * expf(-0.3f * (float)L); }

template <int RMAP, int GK, bool QS>
__device__ __forceinline__ void cvt_item(const float* W, int K, int N, bf16* WT, int ldk, const float* g0, const float* g1, float g1s, LAS float* scr, int item, int lane) {
    const int nblk = N / 32, kb = item / nblk, nb = item % nblk, k0 = 64 * kb, n0 = 32 * nb;
    float cs = 1.f; if (QS) { if (n0 >= 512 && n0 < 1024) cs = QSCALE; }
    float wv[32];
#pragma unroll
    for (int i = 0; i < 32; ++i) { const int k = k0 + 2 * i + (lane >> 5); wv[i] = *(const GAS float*)(W + (size_t)k * N + n0 + (lane & 31)); }
#pragma unroll
    for (int i = 0; i < 32; ++i) { const int kk = 2 * i + (lane >> 5), k = k0 + kk;
        float gv = cs; if (GK == 1) gv *= g0[k]; if (GK == 2) gv *= (k < 512) ? g0[k] : g1[(k - 512) & 127] * g1s;
        scr[kk * 33 + (lane & 31)] = wv[i] * gv; }
    LDS_WAIT(); asm volatile("" ::: "memory");
    const int c = lane & 7;
#pragma unroll
    for (int j = 0; j < 4; ++j) { const int n = (lane >> 3) + 8 * j; const LAS float* s = scr + (8 * c) * 33 + n;
        v4u o; o.x = pk2(s[0 * 33], s[1 * 33]); o.y = pk2(s[2 * 33], s[3 * 33]); o.z = pk2(s[4 * 33], s[5 * 33]); o.w = pk2(s[6 * 33], s[7 * 33]);
        const int nn = n0 + n; const int drow = (RMAP == 0) ? nn : ((nn >> 7) * 256 + (nn & 127) + (RMAP == 2 ? 128 : 0));
        *(GAS v4u*)(WT + (size_t)drow * ldk + k0 + 8 * c) = o; }
    LDS_WAIT(); asm volatile("" ::: "memory");
}
constexpr float MOE_SX = 32.0f, MOE_SWGU = 1016.0f, MOE_SH = 16.0f, MOE_SWDN = 1900.0f;
__device__ __forceinline__ unsigned pk4i8(float a, float b, float c, float d) {
    unsigned w = 0; w = __builtin_amdgcn_cvt_pk_u8_f32(__builtin_rintf(a) + 128.f, 0, w); w = __builtin_amdgcn_cvt_pk_u8_f32(__builtin_rintf(b) + 128.f, 1, w);
    w = __builtin_amdgcn_cvt_pk_u8_f32(__builtin_rintf(c) + 128.f, 2, w); w = __builtin_amdgcn_cvt_pk_u8_f32(__builtin_rintf(d) + 128.f, 3, w); return w ^ 0x80808080u; }
template <int RMAP, int GK>
__device__ __forceinline__ void cvt_item8(const float* W, int K, int N, unsigned char* WT, int ldk, const float* g0, float sw, LAS float* scr, int item, int lane) {
    const int nblk = N / 32, kb = item / nblk, nb = item % nblk, k0 = 64 * kb, n0 = 32 * nb;
    float wv[32];
#pragma unroll
    for (int i = 0; i < 32; ++i) { const int k = k0 + 2 * i + (lane >> 5); wv[i] = *(const GAS float*)(W + (size_t)k * N + n0 + (lane & 31)); }
#pragma unroll
    for (int i = 0; i < 32; ++i) { const int kk = 2 * i + (lane >> 5), k = k0 + kk; float gv = sw; if (GK == 1) gv *= g0[k];
        scr[kk * 33 + (lane & 31)] = wv[i] * gv; }
    LDS_WAIT(); asm volatile("" ::: "memory");
    const int c = lane & 3;
#pragma unroll
    for (int j = 0; j < 2; ++j) { const int n = (lane >> 2) + 16 * j; const LAS float* s = scr + (16 * c) * 33 + n;
        v4u o; o.x = pk4i8(s[0 * 33], s[1 * 33], s[2 * 33], s[3 * 33]); o.y = pk4i8(s[4 * 33], s[5 * 33], s[6 * 33], s[7 * 33]);
        o.z = pk4i8(s[8 * 33], s[9 * 33], s[10 * 33], s[11 * 33]); o.w = pk4i8(s[12 * 33], s[13 * 33], s[14 * 33], s[15 * 33]);
        const int nn = n0 + n; const int drow = (RMAP == 0) ? nn : ((nn >> 7) * 256 + (nn & 127) + (RMAP == 2 ? 128 : 0));
        *(GAS v4u*)(WT + (size_t)drow * ldk + k0 + 16 * c) = o; }
    LDS_WAIT(); asm volatile("" ::: "memory");
}
__device__ __forceinline__ void ssm_tables(Frame& F, int ci);
__device__ __forceinline__ void p0_prologue(Frame& F) {
    LAS float* scr = (LAS float*)(F.lds + RING_OFF + F.wave * 16384);
    const int gw = F.vcu * NWAVES + F.wave, NGW = F.G * NWAVES;
    const ArgView in; unsigned char* ws = F.ws;
    { constexpr int IPM = (DM / 64) * (IN_COLS / 32);
      for (int it = gw; it < DEPTH * IPM; it += NGW) { const int L = it / IPM, r = it % IPM;
        cvt_item8<0, 1>(in[2] + (size_t)L * DM * IN_COLS, DM, IN_COLS, (unsigned char*)(ws + WS_WIN) + (size_t)L * IN_COLS * DM, DM, in[1] + L * DM, MOE_SWGU, scr, r, F.lane); } }
    { constexpr int IPM = (SSM_W / 64) * (SSM_W / 32);
      for (int it = gw; it < DEPTH * IPM; it += NGW) { const int L = it / IPM, r = it % IPM;
        cvt_item<0, 0, false>(in[11] + (size_t)L * SSM_W * SSM_W, SSM_W, SSM_W, (bf16*)(ws + WS_WGLU) + (size_t)L * SSM_W * SSM_W, SSM_W, nullptr, nullptr, 0.f, scr, r, F.lane); } }
    { constexpr int IPM = (DM / 64) * (DM / 32);
      for (int it = gw; it < DEPTH * IPM; it += NGW) { const int L = it / IPM, r = it % IPM;
        cvt_item<0, 2, false>(in[19] + (size_t)L * DM * DM, DM, DM, (bf16*)(ws + WS_WOUT) + (size_t)L * DM * DM, DM, in[13] + L * SSM_W, in[18] + L * ATT_DV, 1.0f - lambda_init(L), scr, r, F.lane); } }
    { constexpr int IPM = (DM / 64) * (DFF / 32);
      for (int it = gw; it < 2 * IPM; it += NGW) { const int j = it / IPM, r = it % IPM; unsigned char* dst = (unsigned char*)(ws + WS_DGU) + (size_t)j * (2 * DFF_P) * DM;
        cvt_item8<1, 1>(in[21] + (size_t)j * DM * DFF, DM, DFF, dst, DM, in[20] + (2 * j) * DM, MOE_SWGU, scr, r, F.lane);
        cvt_item8<2, 1>(in[22] + (size_t)j * DM * DFF, DM, DFF, dst, DM, in[20] + (2 * j) * DM, MOE_SWGU, scr, r, F.lane); }
      for (int it = gw; it < 2 * 128; it += NGW) { const int j = it >> 7, rr = it & 127; const int drow = 21 * 256 + ((rr < 64) ? 64 + rr : 192 + (rr - 64));
        GAS v4u* p = (GAS v4u*)((unsigned char*)(ws + WS_DGU) + ((size_t)j * (2 * DFF_P) + drow) * DM); p[F.lane] = (v4u){0u, 0u, 0u, 0u}; } }
    { constexpr int IPM = (DFF / 64) * (DM / 32);
      for (int it = gw; it < 2 * IPM; it += NGW) { const int j = it / IPM, r = it % IPM;
        cvt_item<0, 0, false>(in[23] + (size_t)j * DFF * DM, DFF, DM, (bf16*)(ws + WS_DDN) + (size_t)j * DM * DFF_P, DFF_P, nullptr, nullptr, 0.f, scr, r, F.lane); }
      for (int it = gw * 64 + F.lane; it < 2 * DM * 8; it += NGW * 64) { const int j = it / (DM * 8), r = (it / 8) % DM, c = it % 8;
        *(GAS v4u*)((bf16*)(ws + WS_DDN) + ((size_t)j * DM + r) * DFF_P + DFF + 8 * c) = (v4u){0u, 0u, 0u, 0u}; } }
    { constexpr int IPM = (DM / 64) * (DFE / 32);
      for (int it = gw; it < 2 * NEXP * IPM; it += NGW) { const int je = it / IPM, r = it % IPM, j = je / NEXP; unsigned char* dst = (unsigned char*)(ws + WS_MGU) + (size_t)je * (2 * DFE) * DM;
        cvt_item8<1, 1>(in[26] + (size_t)je * DM * DFE, DM, DFE, dst, DM, in[20] + (2 * j + 1) * DM, MOE_SWGU, scr, r, F.lane);
        cvt_item8<2, 1>(in[27] + (size_t)je * DM * DFE, DM, DFE, dst, DM, in[20] + (2 * j + 1) * DM, MOE_SWGU, scr, r, F.lane); } }
    { constexpr int IPM = (DFE / 64) * (DM / 32);
      for (int it = gw; it < 2 * NEXP * IPM; it += NGW) { const int je = it / IPM, r = it % IPM;
        cvt_item8<0, 0>(in[28] + (size_t)je * DFE * DM, DFE, DM, (unsigned char*)(ws + WS_MDN) + (size_t)je * DM * DFE, DFE, nullptr, MOE_SWDN, scr, r, F.lane); } }
    for (int it = gw * 64 + F.lane; it < 2 * NEXP * DM; it += NGW * 64) { const int j = it / (NEXP * DM), e = (it / DM) % NEXP, c = it % DM;
        ((float*)(ws + WS_WR))[it] = in[20][(2 * j + 1) * DM + c] * in[24][((size_t)j * DM + c) * NEXP + e]; }
    __syncthreads();
    for (int ci = blockIdx.x; ci < DEPTH * SSM_G * 2; ci += F.G) ssm_tables(F, ci);
    { unsigned long long* ss = (unsigned long long*)(ws + WS_SS) + (size_t)SS_MIXN(0) * M;
      for (int m0 = 2 * gw; m0 < M; m0 += 2 * NGW) {
        f32x4 v[2][4];
#pragma unroll
        for (int u = 0; u < 2; ++u) { const GAS f32x4* xr = (const GAS f32x4*)(in[0] + (size_t)(m0 + u) * DM) + F.lane;
#pragma unroll
          for (int j = 0; j < 4; ++j) v[u][j] = xr[64 * j]; }
#pragma unroll
        for (int u = 0; u < 2; ++u) { const int m = m0 + u;
          GAS unsigned long long* o8 = (GAS unsigned long long*)((bf16*)(ws + WS_XB) + (size_t)m * DM) + F.lane; float s = 0.f;
#pragma unroll
          for (int j = 0; j < 4; ++j) { const f32x4 w = v[u][j]; s += (w.x * w.x + w.y * w.y) + (w.z * w.z + w.w * w.w);
              o8[64 * j] = (unsigned long long)pk2(w.x, w.y) | ((unsigned long long)pk2(w.z, w.w) << 32); }
          s = wave_sum(s); if (F.lane == 0) ss[m] = (unsigned long long)(s * SS_FX);
          const float r = __builtin_amdgcn_rsqf(s * (1.0f / DM) + NORM_EPS) * MOE_SX; GAS unsigned* q4 = (GAS unsigned*)(ws + WS_XQ + (size_t)m * DM) + F.lane;
#pragma unroll
          for (int j = 0; j < 4; ++j) { const f32x4 w = v[u][j]; q4[64 * j] = pk4i8(w.x * r, w.y * r, w.z * r, w.w * r); } } } }
}

__device__ __forceinline__ float gelu_tanh(float y) {
    const float z = 0.7978845608028654f * (y + 0.044715f * y * y * y);
    const float t = 1.0f - 2.0f * __builtin_amdgcn_rcpf(1.0f + __builtin_amdgcn_exp2f(2.8853900817779268f * z));
    return 0.5f * y * (1.0f + t);
}

constexpr int SSM_NFRAG = 144, SSM_TAB_BF = SSM_NFRAG * 1024, SSM_AK_OFF = SSM_TAB_BF, SSM_PT_OFF = SSM_AK_OFF + 6 * 64 * 8, SSM_TAB_BYTES = SSM_PT_OFF + 32 * 64 * 8;
static_assert(SSM_TAB_BYTES == 166912 && (size_t)DEPTH * SSM_G * 2 * SSM_TAB_BYTES <= 41 * MiB, "ssm tables");

__device__ __forceinline__ void cexp_pow(float lre, double lim, float step, int e, float& re, float& im) {
    const float mag = expf((float)e * lre * step);
    double ang = (double)e * lim * (double)step; ang -= 6.283185307179586476925 * rint(ang * 0.15915494309189533577);
    const float af = (float)ang; re = mag * cosf(af); im = mag * sinf(af);
}
__device__ __forceinline__ void ssm_tables(Frame& F, int ci) {
    const ArgView in; const int d = ci & 1, pidx = ((ci >> 6) * 2 + d) * SSM_G + ((ci >> 1) & 31);
    LAS float* pwr = (LAS float*)(F.lds + RING_OFF);
    LAS float* pwi = pwr + 64 * 17;
    LAS float* bbr = pwi + 64 * 17;
    LAS float* bbi = bbr + 64 * 16;
    LAS float* cr = bbi + 64 * 16;
    LAS float* cim = cr + 16 * 64;
    LAS float* Kt = cim + 16 * 64;
    unsigned char* tab = F.ws + WS_SSMT + (size_t)ci * SSM_TAB_BYTES;
    const float step = expf(in[5][pidx]);
    { float* ak = (float*)(tab + SSM_AK_OFF); float* pt = (float*)(tab + SSM_PT_OFF);
      for (int it = F.tid; it < 64 * 55; it += NWAVES * 64) { const int p = it & 63, j = it >> 6;
        const float lre = in[3][pidx * 64 + p]; const double lim = (double)in[4][pidx * 64 + p];
        const int e = j < 17 ? j : (j < 23 ? (16 << (j - 17)) : 16 * (j - 23)); float re, im; cexp_pow(lre, lim, step, e, re, im);
        const int mb = p >> 4, pl = p & 15, hi = (pl >> 1) & 1, qq = (pl & 1) | ((pl >> 2) << 1), slot = (hi * 4 + mb) * 8 + qq;
        if (j < 17) { pwr[p * 17 + j] = re; pwi[p * 17 + j] = im; }
        else if (j < 23) { ak[((j - 17) * 64 + slot) * 2] = re; ak[((j - 17) * 64 + slot) * 2 + 1] = im; }
        else { pt[((j - 23) * 64 + slot) * 2] = re; pt[((j - 23) * 64 + slot) * 2 + 1] = im; } } }
    __syncthreads();
    for (int it = F.tid; it < 64 * 16; it += NWAVES * 64) { const int p = it >> 4, h = it & 15; const float lre = in[3][pidx * 64 + p], limf = in[4][pidx * 64 + p];
        const float ar = pwr[p * 17 + 1], ai = pwi[p * 17 + 1], den = lre * lre + limf * limf;
        const float cfr = ((ar - 1.f) * lre + ai * limf) / den, cfi = (ai * lre - (ar - 1.f) * limf) / den;
        const float br = in[6][((size_t)pidx * 64 + p) * 16 + h], bi = in[7][((size_t)pidx * 64 + p) * 16 + h]; bbr[p * 16 + h] = cfr * br - cfi * bi; bbi[p * 16 + h] = cfr * bi + cfi * br; }
    for (int i = F.tid; i < 1024; i += NWAVES * 64) { cr[i] = in[8][(size_t)pidx * 1024 + i]; cim[i] = in[9][(size_t)pidx * 1024 + i]; }
    __syncthreads();
    { const int h = (F.tid >> 4) & 15, hp = F.tid & 15, t0 = (F.tid >> 8) * 8; float a8[8];
#pragma unroll
      for (int t = 0; t < 8; ++t) a8[t] = 0.f;
      for (int p = 0; p < 64; ++p) { const float c_r = cr[h * 64 + p], c_i = cim[h * 64 + p], b_r = bbr[p * 16 + hp], b_i = bbi[p * 16 + hp];
          const float xr = c_r * b_r - c_i * b_i, xi = c_r * b_i + c_i * b_r;
#pragma unroll
          for (int t = 0; t < 8; ++t) a8[t] += xr * pwr[p * 17 + t0 + t] - xi * pwi[p * 17 + t0 + t]; }
#pragma unroll
      for (int t = 0; t < 8; ++t) Kt[((t0 + t) * 16 + h) * 16 + hp] = a8[t]; }
    __syncthreads();
    for (int it = F.tid; it < SSM_NFRAG * 64; it += NWAVES * 64) { const int f = it >> 6, l = it & 63, i = l & 31, hiA = l >> 5; float v[8];
        const int slr = i >> 4, h = i & 15, sl_eff = d ? 1 - slr : slr;
        if (f < 16) {
#pragma unroll
            for (int q = 0; q < 8; ++q) { const int t = f - 1 + sl_eff; v[q] = (t >= 0 && t < 16) ? Kt[(t * 16 + h) * 16 + 8 * hiA + q] : 0.f; }
        } else if (f < 80) { const int mb = (f - 16) >> 4, sp_ = (f - 16) & 15, p = 16 * mb + (i >> 1), ri = i & 1, e = 15 - sp_; const float wr_ = pwr[p * 17 + e], wi_ = pwi[p * 17 + e];
#pragma unroll
            for (int q = 0; q < 8; ++q) { const float b_r = bbr[p * 16 + 8 * hiA + q], b_i = bbi[p * 16 + 8 * hiA + q]; v[q] = ri == 0 ? wr_ * b_r - wi_ * b_i : wr_ * b_i + wi_ * b_r; }
        } else { const int sp = (f - 80) >> 3, ks = (f - 80) & 7, mb = ks >> 1, half = ks & 1, s = 2 * sp + sl_eff;
#pragma unroll
            for (int q = 0; q < 8; ++q) { const int iblk = 16 * half + (q & 3) + 8 * (q >> 2) + 4 * hiA, p = 16 * mb + (iblk >> 1), ri = iblk & 1;
                const float c_r = cr[h * 64 + p], c_i = cim[h * 64 + p], wr_ = pwr[p * 17 + s + 1], wi_ = pwi[p * 17 + s + 1];
                v[q] = ri == 0 ? c_r * wr_ - c_i * wi_ : -(c_r * wi_ + c_i * wr_); }
        }
        v4u o; o.x = pk2(v[0], v[1]); o.y = pk2(v[2], v[3]); o.z = pk2(v[4], v[5]); o.w = pk2(v[6], v[7]);
        *(GAS v4u*)(tab + (size_t)f * 1024 + l * 16) = o; }
    __syncthreads();
}

namespace ssm {
using bf16x8 = __attribute__((ext_vector_type(8))) short;
using f32x16 = __attribute__((ext_vector_type(16))) float;
typedef __attribute__((address_space(3))) const bf16x8 lbf16x8;
__device__ __forceinline__ bf16x8 lfrag(const LAS unsigned char* base, int f, int lane) { return *(lbf16x8*)(base + f * 1024 + lane * 16); }
__device__ __forceinline__ void lds_copy(LAS unsigned char* dst, const unsigned char* src, int nbytes, int tid) {
    const int wv = __builtin_amdgcn_readfirstlane(tid >> 6), ln = tid & 63;
    for (int o = wv * 1024; o < nbytes; o += NWAVES * 1024)
        __builtin_amdgcn_global_load_lds((const unsigned*)(src + o + ln * 16), (LAS unsigned*)(dst + o), 16, 0, 0);
}
template <int D>
__device__ __forceinline__ void ssm_scan(const LAS unsigned char* wsl, const unsigned char* tab, const bf16* ug  , LAS float* totl, const LAS float* akl  , const LAS float* zt  , unsigned char* xg  , int wave, int lane_) {
    int lane = lane_; asm volatile("" : "+v"(lane));
    const int n = lane & 31, hi = lane >> 5, nrel = D ? 31 - n : n;
    const bf16* ul = ug + ((size_t)(512 * wave + 16 * n) * 16 + 8 * hi);
    const LAS float* ak = akl + hi * 64;
    const float* pt = (const float*)(tab + SSM_PT_OFF) + (nrel * 64 + hi * 32) * 2;
    f32x16 S[4];
#pragma unroll
    for (int mb = 0; mb < 4; ++mb) S[mb] = f32x16{};
#pragma unroll
    for (int h8 = 0; h8 < 16; h8 += 8) {
        bf16x8 uf[8];
#pragma unroll
        for (int e = 0; e < 8; ++e) uf[e] = *(const GAS bf16x8*)(ul + (D ? 15 - (h8 + e) : h8 + e) * 16);
#pragma unroll
        for (int e = 0; e < 8; ++e) {
#pragma unroll
            for (int mb = 0; mb < 4; ++mb) S[mb] = __builtin_amdgcn_mfma_f32_32x32x16_bf16(lfrag(wsl, mb * 16 + h8 + e, lane), uf[e], S[mb], 0, 0, 0);
            if ((e & 1) == 1) asm volatile("" ::: "memory"); } }
    asm volatile("" ::: "memory");
#pragma unroll
    for (int mb = 0; mb < 4; ++mb) {
#pragma unroll
        for (int k = 0; k < 5; ++k) { const int dd = 1 << k; const LAS float* akk = nrel >= dd ? ak + k * 128 : zt;
#pragma unroll
            for (int qq = 0; qq < 8; ++qq) { const f32x2v av = *(const LAS f32x2v*)(akk + (mb * 8 + qq) * 2); const float a_r = av.x, a_i = av.y;
                const float vr = D ? __shfl_down(S[mb][2 * qq], dd, 32) : __shfl_up(S[mb][2 * qq], dd, 32), vi = D ? __shfl_down(S[mb][2 * qq + 1], dd, 32) : __shfl_up(S[mb][2 * qq + 1], dd, 32);
                S[mb][2 * qq] += a_r * vr - a_i * vi; S[mb][2 * qq + 1] += a_r * vi + a_i * vr; }
            asm volatile("" ::: "memory"); }
        if (nrel == 31) {
#pragma unroll
            for (int r = 0; r < 16; ++r) totl[(wave * 2 + hi) * 64 + mb * 16 + r] = S[mb][r]; }
    }
    LDS_WAIT(); __syncthreads();
    f32x2v ptv[4][8];
#pragma unroll
    for (int mb = 0; mb < 4; ++mb)
#pragma unroll
        for (int qq = 0; qq < 8; ++qq) ptv[mb][qq] = *(const GAS f32x2v*)(pt + (mb * 8 + qq) * 2);
#pragma unroll
    for (int mb = 0; mb < 4; ++mb) {
        float cy[16];
#pragma unroll
        for (int r = 0; r < 16; ++r) cy[r] = 0.f;
        const int nprev = D ? 7 - wave : wave;
        for (int j = 0; j < nprev; ++j) { const int w2 = D ? 7 - j : j; const LAS float* tp = totl + (w2 * 2 + hi) * 64 + mb * 16;
#pragma unroll
            for (int qq = 0; qq < 8; ++qq) { const f32x2v av = *(const LAS f32x2v*)(ak + 5 * 128 + (mb * 8 + qq) * 2);
                const float cr_ = cy[2 * qq], ci_ = cy[2 * qq + 1];
                cy[2 * qq] = av.x * cr_ - av.y * ci_ + tp[2 * qq]; cy[2 * qq + 1] = av.x * ci_ + av.y * cr_ + tp[2 * qq + 1]; } }
        float x[16];
#pragma unroll
        for (int qq = 0; qq < 8; ++qq) { const f32x2v pv = ptv[mb][qq];
            float er = D ? __shfl_down(S[mb][2 * qq], 1, 32) : __shfl_up(S[mb][2 * qq], 1, 32), ei = D ? __shfl_down(S[mb][2 * qq + 1], 1, 32) : __shfl_up(S[mb][2 * qq + 1], 1, 32);
            if (nrel == 0) { er = 0.f; ei = 0.f; }
            x[2 * qq] = er + pv.x * cy[2 * qq] - pv.y * cy[2 * qq + 1]; x[2 * qq + 1] = ei + pv.x * cy[2 * qq + 1] + pv.y * cy[2 * qq]; }
        v4u w0, w1; w0.x = pk2(x[0], x[1]); w0.y = pk2(x[2], x[3]); w0.z = pk2(x[4], x[5]); w0.w = pk2(x[6], x[7]); w1.x = pk2(x[8], x[9]); w1.y = pk2(x[10], x[11]); w1.z = pk2(x[12], x[13]); w1.w = pk2(x[14], x[15]);
        *(GAS v4u*)(xg + (2 * mb) * 1024 + lane * 16) = w0; *(GAS v4u*)(xg + (2 * mb + 1) * 1024 + lane * 16) = w1;
        asm volatile("" ::: "memory");
    }
    VM_WAIT(); LDS_WAIT(); __syncthreads();
}
template <int D, int HALF>
__device__ __forceinline__ void ssm_out(f32x16 (&acc)[4], const LAS unsigned char* ktl, const LAS unsigned char* wcl, const bf16x8 (&uf)[16], const unsigned char* xg, int wave, int lane_) {
    int lane = lane_; asm volatile("" : "+v"(lane));
    constexpr int SP_LO = D ? 4 * (1 - HALF) : 4 * HALF;
    bf16x8 xf[8];
#pragma unroll
    for (int ks = 0; ks < 8; ++ks) xf[ks] = *(const GAS bf16x8*)(xg + ks * 1024 + lane * 16);
#pragma unroll
    for (int q = 0; q < 4; ++q) { const int spa = 4 * HALF + q, sp = D ? 7 - spa : spa; f32x16 a = acc[q];
#pragma unroll
        for (int ks = 0; ks < 8; ++ks) a = __builtin_amdgcn_mfma_f32_32x32x16_bf16(lfrag(wcl, (sp - SP_LO) * 8 + ks, lane), xf[ks], a, 0, 0, 0);
#pragma unroll
        for (int sp_ = 0; sp_ < 16; ++sp_) if (sp_ <= 2 * sp + 1) {
            a = __builtin_amdgcn_mfma_f32_32x32x16_bf16(lfrag(ktl, 2 * sp - sp_ + 1, lane), uf[D ? 15 - sp_ : sp_], a, 0, 0, 0);
            if ((sp_ & 3) == 3) asm volatile("" ::: "memory"); }
        acc[q] = a; asm volatile("" ::: "memory"); }
}
template <int HALF>
__device__ __forceinline__ void ssm_epi(const f32x16 (&acc)[4], const bf16x8 (&uf)[16], bf16* Yg  , f32x4 d0, f32x4 d1, int wave, int lane_) {
    int lane = lane_; asm volatile("" : "+v"(lane));
    const int n = lane & 31, hi = lane >> 5;
    bf16* ylb = Yg + (size_t)(512 * wave + 16 * n) * SSM_W + 4 * hi;
    asm volatile("" : "+v"(ylb));
#pragma unroll
    for (int q = 0; q < 4; ++q)
#pragma unroll
        for (int sl = 0; sl < 2; ++sl) { const int t = 2 * (4 * HALF + q) + sl;
            const v4u w = __builtin_bit_cast(v4u, uf[t]);
            const unsigned s0 = hi ? w.x : w.z, s1 = hi ? w.y : w.w;
            const unsigned r0 = (unsigned)__shfl_xor((int)s0, 32), r1 = (unsigned)__shfl_xor((int)s1, 32);
            const unsigned a0 = hi ? r0 : w.x, a1 = hi ? r1 : w.y, b0 = hi ? w.z : r0, b1 = hi ? w.w : r1;
            const float y0 = gelu_tanh(acc[q][8 * sl + 0] + d0.x * __uint_as_float(a0 << 16)), y1 = gelu_tanh(acc[q][8 * sl + 1] + d0.y * __uint_as_float(a0 & 0xffff0000u));
            const float y2 = gelu_tanh(acc[q][8 * sl + 2] + d0.z * __uint_as_float(a1 << 16)), y3 = gelu_tanh(acc[q][8 * sl + 3] + d0.w * __uint_as_float(a1 & 0xffff0000u));
            const float y4 = gelu_tanh(acc[q][8 * sl + 4] + d1.x * __uint_as_float(b0 << 16)), y5 = gelu_tanh(acc[q][8 * sl + 5] + d1.y * __uint_as_float(b0 & 0xffff0000u));
            const float y6 = gelu_tanh(acc[q][8 * sl + 6] + d1.z * __uint_as_float(b1 << 16)), y7 = gelu_tanh(acc[q][8 * sl + 7] + d1.w * __uint_as_float(b1 & 0xffff0000u));
            *(GAS unsigned long long*)(ylb + t * SSM_W) = (unsigned long long)pk2(y0, y1) | ((unsigned long long)pk2(y2, y3) << 32);
            *(GAS unsigned long long*)(ylb + t * SSM_W + 8) = (unsigned long long)pk2(y4, y5) | ((unsigned long long)pk2(y6, y7) << 32); }
}
}
__device__ __forceinline__ void ssm_unit(Frame& F, int L, int unit) {
    const int b = unit >> 5, g = unit & 31; const ArgView in;
    const bf16* ug = (const bf16*)(F.ws + WS_UG) + ((size_t)g * M + (size_t)b * SEQ) * 16;
    LAS float* totl = (LAS float*)(F.lds + LDSCTL_OFF + 4096);
    LAS unsigned char* ring = F.lds + RING_OFF;
    const unsigned char* tab0 = F.ws + WS_SSMT + (size_t)((L * SSM_G + g) * 2) * SSM_TAB_BYTES; const unsigned char* tab1 = tab0 + SSM_TAB_BYTES;
    unsigned char* xg0 = F.ws + WS_SSMX + ((size_t)blockIdx.x * 16 + F.wave) * 8192; unsigned char* xg1 = xg0 + 8 * 8192;
    LAS float* akl = (LAS float*)(F.lds + LDSCTL_OFF + 8192);
    __syncthreads();
    { float akv[3];
#pragma unroll
      for (int q = 0; q < 3; ++q) { const int i = F.tid + q * NWAVES * 64; akv[q] = ((const GAS float*)((i < 768 ? tab0 : tab1) + SSM_AK_OFF))[i < 768 ? i : i - 768]; }
#pragma unroll
      for (int q = 0; q < 3; ++q) akl[F.tid + q * NWAVES * 64] = akv[q]; }
    ssm::lds_copy(ring, tab0 + 16 * 1024, 65536, F.tid); ssm::lds_copy(ring + 65536, tab1 + 16 * 1024, 65536, F.tid);
    VM_WAIT(); LDS_WAIT(); __syncthreads();
    const LAS float* zt = (const LAS float*)(F.lds + LDSCTL_OFF + 14336);
    ssm::ssm_scan<0>(ring, tab0, ug, totl, akl, zt, xg0, F.wave, F.lane);
    ssm::ssm_scan<1>(ring + 65536, tab1, ug, totl, akl + 768, zt, xg1, F.wave, F.lane);
    ssm::bf16x8 uf[16];
    { const bf16* ul = ug + ((size_t)(512 * F.wave + 16 * (F.lane & 31)) * 16 + 8 * (F.lane >> 5));
#pragma unroll
      for (int s_ = 0; s_ < 16; ++s_) uf[s_] = *(const GAS ssm::bf16x8*)(ul + s_ * 16); }
    bf16* Yg = (bf16*)(F.ws + WS_Y) + (size_t)b * SEQ * SSM_W + g * 16; const float* dsk = in[10] + L * SSM_W + g * 16;
    const int hi = F.lane >> 5;
    const f32x4 d0 = *(const f32x4*)(dsk + 4 * hi), d1 = *(const f32x4*)(dsk + 8 + 4 * hi);
    {
        ssm::lds_copy(ring, tab0, 16384, F.tid); ssm::lds_copy(ring + 16384, tab1, 16384, F.tid);
        ssm::lds_copy(ring + 32768, tab0 + 80 * 1024, 32768, F.tid); ssm::lds_copy(ring + 65536, tab1 + 112 * 1024, 32768, F.tid);
        VM_WAIT(); LDS_WAIT(); __syncthreads();
        ssm::f32x16 acc[4];
#pragma unroll
        for (int i = 0; i < 4; ++i) acc[i] = ssm::f32x16{};
        ssm::ssm_out<0, 0>(acc, ring, ring + 32768, uf, xg0, F.wave, F.lane); ssm::ssm_out<1, 0>(acc, ring + 16384, ring + 65536, uf, xg1, F.wave, F.lane);
        ssm::ssm_epi<0>(acc, uf, Yg, d0, d1, F.wave, F.lane); }
    LDS_WAIT(); __syncthreads();
    {
        ssm::lds_copy(ring + 32768, tab0 + 112 * 1024, 32768, F.tid); ssm::lds_copy(ring + 65536, tab1 + 80 * 1024, 32768, F.tid);
        VM_WAIT(); LDS_WAIT(); __syncthreads();
        ssm::f32x16 acc[4];
#pragma unroll
        for (int i = 0; i < 4; ++i) acc[i] = ssm::f32x16{};
        ssm::ssm_out<0, 1>(acc, ring, ring + 32768, uf, xg0, F.wave, F.lane); ssm::ssm_out<1, 1>(acc, ring + 16384, ring + 65536, uf, xg1, F.wave, F.lane);
        ssm::ssm_epi<1>(acc, uf, Yg, d0, d1, F.wave, F.lane); }
    LDS_WAIT(); __syncthreads();
}

__device__ __forceinline__ void attn_unit(Frame& F, int L, int unit, float lam) {
    using namespace att;
    const int qb = unit & 15, h = (unit >> 4) & 3, b = unit >> 6;
    const int tid = F.tid, wid = tid >> 6, lane = tid & 63, r32 = lane & 31, hi = lane >> 5;
    const att::bf16* Qb = (const att::bf16*)(F.ws + WS_Q); const att::bf16* Kb = (const att::bf16*)(F.ws + WS_K); const att::bf16* Vb = (const att::bf16*)(F.ws + WS_V);
    const float slope2 = exp2f(-2.0f * (float)(h + 1)) * 1.4426950408889634f;
    const size_t rowb = (size_t)b * SEQ; const int q0 = qb * 256;
    att::lchar* lds = (att::lchar*)(F.lds + RING_OFF);
    att::lfloat* ws = (att::lfloat*)(lds + 2 * SHM_V + 2 * SHM_K) + wid * 64;
    att::lfloat* wsall = (att::lfloat*)(lds + 2 * SHM_V + 2 * SHM_K);
    const gu32* kmx = F.ctl + CW_KMAX + L * 128 + (b * 4 + h) * 4;
    float k2[2];
#pragma unroll
    for (int mp = 0; mp < 2; ++mp) k2[mp] = __uint_as_float(__hip_atomic_load(kmx + mp * 2, RLX_AGENT)) + __uint_as_float(__hip_atomic_load(kmx + mp * 2 + 1, RLX_AGENT));
#pragma unroll 1
    for (int mp = 0; mp < 2; ++mp) {
        f32x16 o[4]; float l;
        attn_pass(Qb + (rowb + q0 + wid * 32) * LDQ + h * 128 + mp * 64, Kb + rowb * LDQ + h * 128 + mp * 64, Vb + rowb * LDQ + h * 128, (long)((WS_VL - WS_V) / 2), (long)((WS_VR - WS_V) / 2),
                  qb, slope2, mp ? k2[1] : k2[0], lds, o, l);
        if (hi == 0) ws[r32] = l; asm volatile("s_waitcnt lgkmcnt(0)" ::: "memory");
        int un = unit; asm volatile("" : "+s"(un));
        const size_t rowe = (size_t)(un >> 6) * SEQ + (size_t)(un & 15) * 256 + wid * 32; const int he = (un >> 4) & 3;
        float* Aw = (float*)(F.ws + WS_ATMP) + rowe * 512 + he * 128;
        att::bf16* Ow = (att::bf16*)(F.ws + WS_MIX) + rowe * DM + 512 + he * 128;
        if (mp == 0) {
#pragma unroll
            for (int r = 0; r < 16; ++r) { const int orow = crow(r, hi); const float rl = __builtin_amdgcn_rcpf(ws[orow]);
                float* awp = Aw + (size_t)(4 * hi) * 512 + r32; asm volatile("" : "+v"(awp));
#pragma unroll
                for (int d0 = 0; d0 < 4; ++d0) *(GAS float*)(awp + crow(r, 0) * 512 + d0 * 32) = o[d0][r] * rl; }
        } else {
            float a0v[16][4]; unsigned long long ssv[16];
            { const float* awp = Aw + (size_t)(4 * hi) * 512 + r32; asm volatile("" : "+v"(awp));
              const unsigned long long* ssp = (const unsigned long long*)(F.ws + WS_SS) + (size_t)SS_GLU(L) * M + rowe + 4 * hi; asm volatile("" : "+v"(ssp));
#pragma unroll
              for (int r = 0; r < 16; ++r) {
#pragma unroll
                  for (int d0 = 0; d0 < 4; ++d0) a0v[r][d0] = *(const GAS float*)(awp + crow(r, 0) * 512 + d0 * 32);
                  ssv[r] = *(const GAS unsigned long long*)(ssp + crow(r, 0)); } }
#pragma unroll
            for (int r = 0; r < 16; ++r) { const int orow = crow(r, hi); const float rl = __builtin_amdgcn_rcpf(ws[orow]) * lam; float v[4]; float sq = 0.f;
#pragma unroll
                for (int d0 = 0; d0 < 4; ++d0) { v[d0] = a0v[r][d0] - o[d0][r] * rl; sq += v[d0] * v[d0]; }
                sq += __shfl_xor(sq, 1); sq += __shfl_xor(sq, 2); sq += __shfl_xor(sq, 4); sq += __shfl_xor(sq, 8); sq += __shfl_xor(sq, 16);
                const float invrg = sqrtf((float)ssv[r] * SS_FX_INV * (1.0f / SSM_W) + NORM_EPS);
                const float sc = invrg * __builtin_amdgcn_rsqf(sq * (1.0f / ATT_DV) + NORM_EPS);
                att::bf16* owp = Ow + (size_t)(4 * hi) * DM + r32; asm volatile("" : "+v"(owp));
#pragma unroll
                for (int d0 = 0; d0 < 4; ++d0) *(GAS att::bf16*)(owp + crow(r, 0) * DM + d0 * 32) = (att::bf16)f2bf(v[d0] * sc); }
        }
        asm volatile("s_waitcnt vmcnt(0) lgkmcnt(0)" ::: "memory");
        __syncthreads();
    }
}
__device__ __forceinline__ void attn_phase(Frame& F, int L, int rep = 0) {
    const ArgView in;
    const float d1 = wave_sum(in[14][L * 64 + F.lane] * in[15][L * 64 + F.lane]), d2 = wave_sum(in[16][L * 64 + F.lane] * in[17][L * 64 + F.lane]);
    const float lam = expf(d1) - expf(d2) + lambda_init(L);
    LAS int* qslot = (LAS int*)(F.lds + LDSCTL_OFF + 2048);
    gu32* qctr = F.ctl + CW_ATTQ + rep * 256 + L * 64;
    const int x0 = (int)(xb_xcc_id() & 7u);
    int qi = 0;
    for (;;) {
        if (F.tid == 0) { int got = -1;
            while (qi < 8) { const int q = (x0 + qi) & 7; const unsigned idx = __hip_atomic_fetch_add(qctr + q * 8, 1u, RLX_AGENT);
                if (idx < (unsigned)(ATT_H * (SEQ / 256))) { got = (q << 6) | (int)idx; break; } ++qi; }
            qslot[0] = got; qslot[1] = qi; }
        LDS_WAIT(); __syncthreads();
        const int got = __builtin_amdgcn_readfirstlane(qslot[0]); qi = __builtin_amdgcn_readfirstlane(qslot[1]);
        __syncthreads();
        if (got < 0) break;
        const int b = got >> 6, idx = got & 63, h = 3 - (idx >> 4), qb = idx & 15;
        attn_unit(F, L, (b << 6) | (h << 4) | qb, lam);
    }
}

constexpr size_t WS_SSG = WS_WR + 128 * 1024;
static_assert(WS_SSG + (size_t)MOE_ROWS * 8 <= WS_WIN, "ssg fits behind the router weights");
__device__ __forceinline__ float grp16_sum(float v) { v += __shfl_xor(v, 1); v += __shfl_xor(v, 2); v += __shfl_xor(v, 4); v += __shfl_xor(v, 8); return v; }
__device__ __forceinline__ void moe_route(Frame& F, int j) {
    const float* wr = (const float*)(F.ws + WS_WR) + (size_t)j * NEXP * DM; const float* br = (const float*)argt(25) + j * NEXP;
    int* r_e = (int*)(F.ws + WS_ROUTE); int* r_pos = r_e + 2 * M; float* r_w = (float*)(r_pos + 2 * M);
    gu32* cnt = F.ctl + CW_ROUTE + j * 64;
    LAS float* wl = (LAS float*)(F.lds + RING_OFF);
    LAS unsigned* lcnt = (LAS unsigned*)(F.lds + RING_OFF + 32768);
    ssm::lds_copy((LAS unsigned char*)wl, (const unsigned char*)wr, NEXP * DM * 4, F.tid);
    if (F.tid < 16) lcnt[F.tid] = 0u;
    VM_WAIT(); LDS_WAIT(); __syncthreads();
    const int g = F.lane >> 4, t = F.lane & 15;
    const int gw = F.vcu * NWAVES + F.wave, NGW = F.G * NWAVES, NBLK = M / 16, nit = (NBLK + NGW - 1) / NGW;
    float bias[NEXP];
#pragma unroll
    for (int e = 0; e < NEXP; ++e) bias[e] = br[e];
    for (int it = 0; it < nit; ++it) {
        const int blk = it * NGW + gw; const bool valid = blk < NBLK;
        int e0s[4], e1s[4], l0s[4], l1s[4]; float w0s[4];
#pragma unroll
        for (int bb = 0; bb < 4; ++bb) {
            const int m = blk * 16 + bb * 4 + g; e0s[bb] = 0; e1s[bb] = 1; l0s[bb] = 0; l1s[bb] = 0; w0s[bb] = 0.f;
            if (valid) {
                const GAS unsigned long long* xr = (const GAS unsigned long long*)((const bf16*)(F.ws + WS_XB) + (size_t)m * DM) + t; unsigned long long xw[16]; f32x4 x[16]; float ss = 0.f, dot[NEXP];
#pragma unroll
                for (int i = 0; i < 16; ++i) xw[i] = xr[16 * i];
#pragma unroll
                for (int i = 0; i < 16; ++i) { const unsigned a0 = (unsigned)xw[i], a1 = (unsigned)(xw[i] >> 32); x[i] = (f32x4){__uint_as_float(a0 << 16), __uint_as_float(a0 & 0xffff0000u), __uint_as_float(a1 << 16), __uint_as_float(a1 & 0xffff0000u)}; }
#pragma unroll
                for (int e = 0; e < NEXP; ++e) dot[e] = 0.f;
#pragma unroll
                for (int i = 0; i < 16; ++i) { ss += (x[i].x * x[i].x + x[i].y * x[i].y) + (x[i].z * x[i].z + x[i].w * x[i].w);
#pragma unroll
                    for (int e = 0; e < NEXP; ++e) { const f32x4 w = *(const LAS f32x4*)(wl + e * DM + 64 * i + 4 * t); dot[e] += (x[i].x * w.x + x[i].y * w.y) + (x[i].z * w.z + x[i].w * w.w); } }
                ss = grp16_sum(ss); const float r = 1.0f / sqrtf(ss * (1.0f / DM) + NORM_EPS);
                float lg[NEXP];
#pragma unroll
                for (int e = 0; e < NEXP; ++e) lg[e] = grp16_sum(dot[e]) * r + bias[e];
                int i0 = 0; float v0 = lg[0];
#pragma unroll
                for (int e = 1; e < NEXP; ++e) if (lg[e] > v0) { v0 = lg[e]; i0 = e; }
                int i1 = -1; float v1 = -3.0e38f;
#pragma unroll
                for (int e = 0; e < NEXP; ++e) if (e != i0 && lg[e] > v1) { v1 = lg[e]; i1 = e; }
                e0s[bb] = i0; e1s[bb] = i1; w0s[bb] = 1.0f / (1.0f + expf(v1 - v0));
                if (t == 0) { l0s[bb] = (int)__hip_atomic_fetch_add(lcnt + i0, 1u, __ATOMIC_RELAXED, __HIP_MEMORY_SCOPE_WORKGROUP); l1s[bb] = (int)__hip_atomic_fetch_add(lcnt + i1, 1u, __ATOMIC_RELAXED, __HIP_MEMORY_SCOPE_WORKGROUP); }
            }
        }
        LDS_WAIT(); __syncthreads();
        if (F.tid < NEXP) { const unsigned n = lcnt[F.tid]; lcnt[8 + F.tid] = n ? __hip_atomic_fetch_add(cnt + F.tid, n, RLX_AGENT) : 0u; }
        LDS_WAIT(); __syncthreads();
        if (valid && t == 0) {
#pragma unroll
            for (int bb = 0; bb < 4; ++bb) { const int m = blk * 16 + bb * 4 + g;
                r_e[2 * m] = e0s[bb]; r_e[2 * m + 1] = e1s[bb]; r_pos[2 * m] = (int)lcnt[8 + e0s[bb]] + l0s[bb]; r_pos[2 * m + 1] = (int)lcnt[8 + e1s[bb]] + l1s[bb];
                r_w[2 * m] = w0s[bb]; r_w[2 * m + 1] = 1.0f - w0s[bb]; } }
        __syncthreads();
        if (F.tid < 8) lcnt[F.tid] = 0u;
        LDS_WAIT(); __syncthreads();
    }
}
__device__ __forceinline__ void moe_tile_offsets(Frame& F, int j, int (&toff)[9]) {
    gu32* cnt = F.ctl + CW_ROUTE + j * 64; int acc = 0;
    const unsigned nv = __hip_atomic_load(cnt + (F.lane & 7), RLX_AGENT);
#pragma unroll
    for (int e = 0; e < NEXP; ++e) { toff[e] = acc; const unsigned n = (unsigned)__builtin_amdgcn_readlane((int)nv, e); acc += (int)((n + 255u) >> 8); }
    toff[8] = acc;
}
__device__ __forceinline__ void moe_gather(Frame& F, int j, int L) {
    int toff[9]; moe_tile_offsets(F, j, toff);
    int* r_e = (int*)(F.ws + WS_ROUTE); int* r_pos = r_e + 2 * M;
    unsigned char* XG = F.ws + WS_XG; const bf16* XB = (const bf16*)(F.ws + WS_XB);
    const unsigned long long* ssx = (const unsigned long long*)(F.ws + WS_SS) + (size_t)SS_FFN(L) * M;
    const int gw = F.vcu * NWAVES + F.wave, NGW = F.G * NWAVES;
    for (int m0 = gw * 8; m0 < M; m0 += NGW * 8) {
        v4u a[8][2];
        const int re_v = r_e[2 * m0 + (F.lane & 15)], rp_v = r_pos[2 * m0 + (F.lane & 15)]; const float ss_v = (float)ssx[m0 + (F.lane & 7)];
#pragma unroll
        for (int u = 0; u < 8; ++u) { const GAS v4u* src = (const GAS v4u*)(XB + (size_t)(m0 + u) * DM) + 2 * F.lane; a[u][0] = src[0]; a[u][1] = src[1]; }
#pragma unroll
        for (int u = 0; u < 8; ++u) { const int m = m0 + u;
            const float r = __builtin_amdgcn_rsqf(__uint_as_float(__builtin_amdgcn_readlane(__float_as_uint(ss_v), u)) * SS_FX_INV * (1.0f / DM) + NORM_EPS) * MOE_SX;
            v4u b;
            { const v4u w0 = a[u][0], w1 = a[u][1];
              b.x = pk4i8(__uint_as_float(w0.x << 16) * r, __uint_as_float(w0.x & 0xffff0000u) * r, __uint_as_float(w0.y << 16) * r, __uint_as_float(w0.y & 0xffff0000u) * r);
              b.y = pk4i8(__uint_as_float(w0.z << 16) * r, __uint_as_float(w0.z & 0xffff0000u) * r, __uint_as_float(w0.w << 16) * r, __uint_as_float(w0.w & 0xffff0000u) * r);
              b.z = pk4i8(__uint_as_float(w1.x << 16) * r, __uint_as_float(w1.x & 0xffff0000u) * r, __uint_as_float(w1.y << 16) * r, __uint_as_float(w1.y & 0xffff0000u) * r);
              b.w = pk4i8(__uint_as_float(w1.z << 16) * r, __uint_as_float(w1.z & 0xffff0000u) * r, __uint_as_float(w1.w << 16) * r, __uint_as_float(w1.w & 0xffff0000u) * r); }
#pragma unroll
            for (int k = 0; k < 2; ++k) { const int e = __builtin_amdgcn_readlane(re_v, 2 * u + k), pos = __builtin_amdgcn_readlane(rp_v, 2 * u + k); int t0 = 0;
#pragma unroll
                for (int q = 0; q < NEXP; ++q) t0 = (e == q) ? toff[q] : t0;
                const int dest = t0 * 256 + pos;
                ((GAS v4u*)(XG + (size_t)dest * DM))[F.lane] = b;
                if (F.lane == 0) r_pos[2 * m + k] = dest; } }
    }
}
__device__ __forceinline__ void ffn_quant(Frame& F, int ssi) {
    unsigned char* XQ = F.ws + WS_XQ; const bf16* XB = (const bf16*)(F.ws + WS_XB);
    const unsigned long long* ssx = (const unsigned long long*)(F.ws + WS_SS) + (size_t)ssi * M;
    const int gw = F.vcu * NWAVES + F.wave, NGW = F.G * NWAVES;
    for (int m0 = gw * 8; m0 < M; m0 += NGW * 8) {
        v4u a[8][2];
        const float ss_v = (float)ssx[m0 + (F.lane & 7)];
#pragma unroll
        for (int u = 0; u < 8; ++u) { const GAS v4u* src = (const GAS v4u*)(XB + (size_t)(m0 + u) * DM) + 2 * F.lane; a[u][0] = src[0]; a[u][1] = src[1]; }
#pragma unroll
        for (int u = 0; u < 8; ++u) { const int m = m0 + u;
            const float r = __builtin_amdgcn_rsqf(__uint_as_float(__builtin_amdgcn_readlane(__float_as_uint(ss_v), u)) * SS_FX_INV * (1.0f / DM) + NORM_EPS) * MOE_SX;
            const v4u w0 = a[u][0], w1 = a[u][1]; v4u b;
            b.x = pk4i8(__uint_as_float(w0.x << 16) * r, __uint_as_float(w0.x & 0xffff0000u) * r, __uint_as_float(w0.y << 16) * r, __uint_as_float(w0.y & 0xffff0000u) * r);
            b.y = pk4i8(__uint_as_float(w0.z << 16) * r, __uint_as_float(w0.z & 0xffff0000u) * r, __uint_as_float(w0.w << 16) * r, __uint_as_float(w0.w & 0xffff0000u) * r);
            b.z = pk4i8(__uint_as_float(w1.x << 16) * r, __uint_as_float(w1.x & 0xffff0000u) * r, __uint_as_float(w1.y << 16) * r, __uint_as_float(w1.y & 0xffff0000u) * r);
            b.w = pk4i8(__uint_as_float(w1.z << 16) * r, __uint_as_float(w1.z & 0xffff0000u) * r, __uint_as_float(w1.w << 16) * r, __uint_as_float(w1.w & 0xffff0000u) * r);
            ((GAS v4u*)(XQ + (size_t)m * DM))[F.lane] = b; }
    }
}
__device__ __forceinline__ void moe_combine(Frame& F, int L, bool last) {
    const int* r_e = (const int*)(F.ws + WS_ROUTE); const int* r_pos = r_e + 2 * M; const float* r_w = (const float*)(r_pos + 2 * M);
    const bf16* YE = (const bf16*)(F.ws + WS_XG);
    unsigned long long* ss = (unsigned long long*)(F.ws + WS_SS) + (size_t)SS_MIXN(last ? 0 : L + 1) * M;
    const float* gfin = (const float*)argt(29);
    const int g = F.lane >> 4, t = F.lane & 15;
    const int gw = F.vcu * NWAVES + F.wave, NGW = F.G * NWAVES;
    int d0n = 0, d1n = 0; float w0n = 0.f, w1n = 0.f;
    { const int mf = gw * 4 + g; if (mf < M) { d0n = r_pos[2 * mf]; d1n = r_pos[2 * mf + 1]; w0n = r_w[2 * mf]; w1n = r_w[2 * mf + 1]; } }
    for (int m0 = gw * 4; m0 < M; m0 += NGW * 4) { const int m = m0 + g;
        GAS f32x4* xr = (GAS f32x4*)(F.out + (size_t)m * DM) + t; GAS unsigned long long* xb = (GAS unsigned long long*)((bf16*)(F.ws + WS_XB) + (size_t)m * DM) + t;
        const int d0 = d0n, d1 = d1n; const float w0 = w0n, w1 = w1n;
        { const int mn = m + NGW * 4; if (mn < M) { d0n = r_pos[2 * mn]; d1n = r_pos[2 * mn + 1]; w0n = r_w[2 * mn]; w1n = r_w[2 * mn + 1]; } }
        const GAS unsigned long long* y0 = (const GAS unsigned long long*)(YE + (size_t)d0 * DM) + t; const GAS unsigned long long* y1 = (const GAS unsigned long long*)(YE + (size_t)d1 * DM) + t;
        f32x4 v[16]; unsigned long long ya[16], yb[16]; float s = 0.f;
#pragma unroll
        for (int i = 0; i < 16; ++i) { const unsigned long long xw = xb[16 * i]; const unsigned a0 = (unsigned)xw, a1 = (unsigned)(xw >> 32);
            v[i] = (f32x4){__uint_as_float(a0 << 16), __uint_as_float(a0 & 0xffff0000u), __uint_as_float(a1 << 16), __uint_as_float(a1 & 0xffff0000u)}; ya[i] = y0[16 * i]; yb[i] = y1[16 * i]; }
#pragma unroll
        for (int i = 0; i < 16; ++i) { const unsigned a0 = (unsigned)ya[i], a1 = (unsigned)(ya[i] >> 32), c0 = (unsigned)yb[i], c1 = (unsigned)(yb[i] >> 32);
            v[i].x += w0 * __uint_as_float(a0 << 16) + w1 * __uint_as_float(c0 << 16);
            v[i].y += w0 * __uint_as_float(a0 & 0xffff0000u) + w1 * __uint_as_float(c0 & 0xffff0000u);
            v[i].z += w0 * __uint_as_float(a1 << 16) + w1 * __uint_as_float(c1 << 16);
            v[i].w += w0 * __uint_as_float(a1 & 0xffff0000u) + w1 * __uint_as_float(c1 & 0xffff0000u);
            s += (v[i].x * v[i].x + v[i].y * v[i].y) + (v[i].z * v[i].z + v[i].w * v[i].w); }
        s = grp16_sum(s);
        if (!last) {
#pragma unroll
            for (int i = 0; i < 16; ++i) xb[16 * i] = (unsigned long long)pk2(v[i].x, v[i].y) | ((unsigned long long)pk2(v[i].z, v[i].w) << 32);
            if (t == 0) ss[m] = (unsigned long long)(s * SS_FX);
            { const float rq = __builtin_amdgcn_rsqf(s * (1.0f / DM) + NORM_EPS) * MOE_SX; GAS unsigned* q4 = (GAS unsigned*)(F.ws + WS_XQ + (size_t)m * DM) + t;
#pragma unroll
              for (int i = 0; i < 16; ++i) q4[16 * i] = pk4i8(v[i].x * rq, v[i].y * rq, v[i].z * rq, v[i].w * rq); }
        } else {
            const float r = 1.0f / sqrtf(s * (1.0f / DM) + NORM_EPS); const GAS f32x4* gf = (const GAS f32x4*)gfin + t;
#pragma unroll
            for (int i = 0; i < 16; ++i) { const f32x4 gq = gf[16 * i]; xr[16 * i] = (f32x4){v[i].x * r * gq.x, v[i].y * r * gq.y, v[i].z * r * gq.z, v[i].w * r * gq.w}; }
        }
    }
}

#ifndef PROBE_SPIN_MASK
#define PROBE_SPIN_MASK 0
#endif

#ifndef PROBE_P02
#define PROBE_P02 0
#endif
#ifndef PROBE_MOE2
#define PROBE_MOE2 0
#endif
#ifndef PROBE_DGU2
#define PROBE_DGU2 0
#endif
#ifndef PROBE_INP2
#define PROBE_INP2 0
#endif

#ifndef PROBE_ATT2
#define PROBE_ATT2 0
#endif
#ifndef PROBE_SSM2
#define PROBE_SSM2 0
#endif

#ifndef EN_ALL
#define EN_ALL 1
#endif
#ifndef EN_P0
#define EN_P0 EN_ALL
#endif
#ifndef EN_INPROJ
#define EN_INPROJ EN_ALL
#endif
#ifndef EN_SSM
#define EN_SSM EN_ALL
#endif
#ifndef EN_GLU
#define EN_GLU EN_ALL
#endif
#ifndef EN_ATT
#define EN_ATT EN_ALL
#endif
#ifndef EN_OUT
#define EN_OUT EN_ALL
#endif
#ifndef EN_DGU
#define EN_DGU EN_ALL
#endif
#ifndef EN_DDN
#define EN_DDN EN_ALL
#endif
#ifndef EN_ROUTE
#define EN_ROUTE EN_ALL
#endif
#ifndef EN_MGU
#define EN_MGU EN_ALL
#endif
#ifndef EN_MDN
#define EN_MDN EN_ALL
#endif

#define PHASE_FN __device__ __forceinline__ void
PHASE_FN ph_prologue() { Frame F = make_frame(); p0_prologue(F); }
PHASE_FN ph_inproj(int L) {
    Frame F = make_frame(); unsigned char* ws = F.ws;
    pg8::Gemm g{(const bf16*)(ws + WS_XQ), (const bf16*)(ws + WS_WIN + (size_t)L * IN_COLS * DM), M, IN_COLS, DM, 0}; pg8::StaticOrder S; S.init(M, IN_COLS, F.G, (int)blockIdx.x, 2);
    pg8::EpiInProj<true> E{(bf16*)(ws + WS_UG), (bf16*)(ws + WS_Q), (size_t)(WS_K - WS_Q) / 2, nullptr, (size_t)(WS_VL - WS_V) / 2, (size_t)(WS_VR - WS_V) / 2, (unsigned*)(F.ctl + CW_KMAX + L * 128), 1.0f / (MOE_SX * MOE_SWGU)};
    static_assert(WS_V - WS_K == WS_K - WS_Q, "q | k | v sections equally spaced");
    pg8::gemm_phase<pg8::EpiInProj<true>, pg8::StaticOrder, true, true, 1>(F.lds + RING_OFF, g, S, E);
}
PHASE_FN ph_ssm(int L) { Frame F = make_frame(); for (int u = blockIdx.x; u < BATCH * SSM_G; u += F.G) ssm_unit(F, L, u); }
PHASE_FN ph_glu(int L) {
    Frame F = make_frame(); unsigned char* ws = F.ws; unsigned long long* SS = (unsigned long long*)(ws + WS_SS);
    pg8::Gemm g{(const bf16*)(ws + WS_Y), (const bf16*)(ws + WS_WGLU) + (size_t)L * SSM_W * SSM_W, M, SSM_W, SSM_W, 0}; pg8::StaticOrder S; S.init(M, SSM_W, F.G, (int)blockIdx.x);
    pg8::EpiGLU E{(const bf16*)(ws + WS_Y), (bf16*)(ws + WS_MIX), (const float*)argt(12) + L * SSM_W, SS + (size_t)SS_GLU(L) * M};
    pg8::gemm_phase<pg8::EpiGLU, pg8::StaticOrder, true, true>(F.lds + RING_OFF, g, S, E);
}
PHASE_FN ph_attn(int L, int rep) { Frame F = make_frame(); attn_phase(F, L, rep); }
PHASE_FN ph_outproj(int L) {
    Frame F = make_frame(); unsigned char* ws = F.ws; unsigned long long* SS = (unsigned long long*)(ws + WS_SS);
    pg8::Gemm g{(const bf16*)(ws + WS_MIX), (const bf16*)(ws + WS_WOUT) + (size_t)L * DM * DM, M, DM, DM, 0}; pg8::StaticOrder S; S.init(M, DM, F.G, (int)blockIdx.x);
    pg8::EpiResid<false> E{(bf16*)(ws + WS_XB), SS + (size_t)SS_GLU(L) * M, 1.0f / SSM_W, SS + (size_t)SS_FFN(L) * M, 1.0f};
    pg8::gemm_phase<pg8::EpiResid<false>, pg8::StaticOrder, true, true>(F.lds + RING_OFF, g, S, E);
}
PHASE_FN ph_quant(int ssi) { Frame F = make_frame(); ffn_quant(F, ssi); }
PHASE_FN ph_dense_gu(int L) {
    Frame F = make_frame(); unsigned char* ws = F.ws; const int j = L >> 1;
    pg8::Gemm g{(const bf16*)(ws + WS_XQ), (const bf16*)(ws + WS_DGU + (size_t)j * (2 * DFF_P) * DM), M, 2 * DFF_P, DM, 0}; pg8::StaticOrder S; S.init(M, 2 * DFF_P, F.G, (int)blockIdx.x);
    pg8::EpiGateUp8<false> E{ws + WS_HD, DFF_P, 1.0f / (MOE_SX * MOE_SWGU), 1.0f};
    pg8::gemm_phase<pg8::EpiGateUp8<false>, pg8::StaticOrder, true, true, 1>(F.lds + RING_OFF, g, S, E);
}
PHASE_FN ph_dense_dn(int L) {
    Frame F = make_frame(); unsigned char* ws = F.ws; unsigned long long* SS = (unsigned long long*)(ws + WS_SS); const int j = L >> 1;
    pg8::Gemm g{(const bf16*)(ws + WS_HD), (const bf16*)(ws + WS_DDN) + (size_t)j * DM * DFF_P, M, DM, DFF_P, 0}; pg8::StaticOrder S; S.init(M, DM, F.G, (int)blockIdx.x);
    pg8::EpiResid<false> E{(bf16*)(ws + WS_XB), nullptr, 0.f, SS + (size_t)SS_MIXN(L + 1) * M, 1.0f};
    pg8::gemm_phase<pg8::EpiResid<false>, pg8::StaticOrder, true, true>(F.lds + RING_OFF, g, S, E);
}
PHASE_FN ph_route(int j) { Frame F = make_frame(); moe_route(F, j); }
PHASE_FN ph_gather(int j, int L) { Frame F = make_frame(); moe_gather(F, j, L); }
PHASE_FN ph_moe_gu(int j, int ch) {
    Frame F = make_frame(); unsigned char* ws = F.ws;
    pg8::ChunkOrder S; int toff[9]; moe_tile_offsets(F, j, toff);
    { LAS int* tl = (LAS int*)(F.lds + LDSCTL_OFF + 3072); __syncthreads(); if (F.tid < 9) { int v = 0;
#pragma unroll
        for (int q = 0; q < 9; ++q) v = (F.tid == q) ? toff[q] : v;
        tl[F.tid] = v; } LDS_WAIT(); __syncthreads(); S.toff = tl; }
    const int tlo = ch * HM_TILES, thi = (toff[8] < tlo + HM_TILES) ? toff[8] : tlo + HM_TILES, nT = thi > tlo ? thi - tlo : 0;
    S.nM = nT; S.nN = (2 * DFE) / 256; S.nwg = S.nM * S.nN; S.G = F.G; S.c = (int)blockIdx.x; S.tlo = tlo;
    pg8::Gemm g{(const bf16*)(ws + WS_XG), (const bf16*)(ws + WS_MGU + (size_t)j * NEXP * (2 * DFE) * DM), MOE_ROWS, 2 * DFE, DM, (size_t)(2 * DFE) * DM};
    pg8::EpiGateUp8<true> E{ws + WS_HM - (size_t)tlo * 256 * DFE, DFE, 1.0f / (MOE_SX * MOE_SWGU), MOE_SH};
    pg8::gemm_phase<pg8::EpiGateUp8<true>, pg8::ChunkOrder, true, true, 1>(F.lds + RING_OFF, g, S, E);
}
PHASE_FN ph_moe_dn(int j, int ch) {
    Frame F = make_frame(); unsigned char* ws = F.ws;
    pg8::ChunkOrder S; int toff[9]; moe_tile_offsets(F, j, toff);
    { LAS int* tl = (LAS int*)(F.lds + LDSCTL_OFF + 3072); __syncthreads(); if (F.tid < 9) { int v = 0;
#pragma unroll
        for (int q = 0; q < 9; ++q) v = (F.tid == q) ? toff[q] : v;
        tl[F.tid] = v; } LDS_WAIT(); __syncthreads(); S.toff = tl; }
    const int tlo = ch * HM_TILES, thi = (toff[8] < tlo + HM_TILES) ? toff[8] : tlo + HM_TILES, nT = thi > tlo ? thi - tlo : 0;
    S.nM = nT; S.nN = DM / 256; S.nwg = S.nM * S.nN; S.G = F.G; S.c = (int)blockIdx.x; S.tlo = tlo;
    pg8::Gemm g{(const bf16*)(ws + WS_HM - (size_t)tlo * 256 * DFE), (const bf16*)(ws + WS_MDN + (size_t)j * NEXP * DM * DFE), MOE_ROWS, DM, DFE, (size_t)DM * DFE};
    pg8::EpiStoreBf16<true> E{(bf16*)(ws + WS_XG), DM, 1.0f / (MOE_SH * MOE_SWDN)};
    pg8::gemm_phase<pg8::EpiStoreBf16<true>, pg8::ChunkOrder, true, true, 1>(F.lds + RING_OFF, g, S, E);
}
PHASE_FN ph_combine(int L) { Frame F = make_frame(); moe_combine(F, L, L == DEPTH - 1); }

constexpr int N_PHASE_IDS = 1 + 12 * DEPTH;
__global__ void __launch_bounds__(NWAVES * 64, 2) fwd_kernel(Args args) {
    LAS unsigned char* lds = (LAS unsigned char*)g_lds;
    for (int u = threadIdx.x; u < (LDS_BYTES - LDSCTL_OFF) / 4; u += NWAVES * 64) ((LAS unsigned*)(lds + LDSCTL_OFF))[u] = 0u;
    __syncthreads();
    if (threadIdx.x < 32) { unsigned long long v;
        if (threadIdx.x < 30) v = (unsigned long long)args.in[threadIdx.x < 30 ? threadIdx.x : 0]; else if (threadIdx.x == 30) v = (unsigned long long)args.out; else v = (unsigned long long)args.ws;
        ((LAS unsigned long long*)(lds + ARGT_OFF))[threadIdx.x] = v; }
    __syncthreads();
    XcdBarrier bar = xcd_barrier_post((unsigned*)((gu32*)(args.ws + WS_CTL) + CW_BAR), (volatile LAS unsigned*)(lds + MISC_OFF) + 8);
    const int lo = args.ph_lo, hi = args.ph_hi;
#define IN(k) (lo <= (k) && (k) < hi)
#define SEAM(k) do { if (hi > (k) + 1) xcd_barrier(bar); } while (0)
#define PH(kind, ...) do { const unsigned long long t0_ = (PROBE_SPIN_MASK >> (kind)) & 1 ? rt() : 0ull; __VA_ARGS__; \
    if ((PROBE_SPIN_MASK >> (kind)) & 1) probe_acc += rt() - t0_; } while (0)
    unsigned long long probe_acc = 0ull;
    if (EN_P0 && IN(0)) PH(1, ph_prologue(); if (PROBE_P02) ph_prologue(); SEAM(0));
#pragma unroll 1
    for (int L = 0; L < DEPTH; ++L) {
        const int pb = 1 + 12 * L;
        if (EN_INPROJ && IN(pb + 0)) PH(2, ph_inproj(L); if (PROBE_INP2) ph_inproj(L); SEAM(pb + 0));
        if (EN_SSM && IN(pb + 1)) PH(3, ph_ssm(L); if (PROBE_SSM2) ph_ssm(L); SEAM(pb + 1));
        if (EN_GLU && IN(pb + 2)) PH(4, ph_glu(L); SEAM(pb + 2));
        if (EN_ATT && IN(pb + 3)) PH(5, ph_attn(L, 0); if (PROBE_ATT2) ph_attn(L, 1); SEAM(pb + 3));
        if (EN_OUT && IN(pb + 4)) PH(6, ph_outproj(L); SEAM(pb + 4));
        if ((L & 1) == 0) {
            if (EN_DGU && IN(pb + 5)) PH(9, ph_quant(SS_FFN(L)); SEAM(pb + 5));
            if (EN_DGU && IN(pb + 6)) PH(7, ph_dense_gu(L); if (PROBE_DGU2) ph_dense_gu(L); SEAM(pb + 6));
            if (EN_DDN && IN(pb + 7)) PH(8, ph_dense_dn(L); SEAM(pb + 7));
            if (EN_DDN && IN(pb + 8)) PH(9, ph_quant(SS_MIXN(L + 1)); SEAM(pb + 8));
        } else {
            const int j = L >> 1;
            if (EN_ROUTE && IN(pb + 5)) PH(9, ph_route(j); SEAM(pb + 5));
            if (EN_ROUTE && IN(pb + 6)) PH(10, ph_gather(j, L); SEAM(pb + 6));
#pragma unroll 1
            for (int ch = 0; ch < 1; ++ch) {
                if (EN_MGU && IN(pb + 7 + 2 * ch)) PH(11, ph_moe_gu(j, ch); if (PROBE_MOE2) ph_moe_gu(j, ch); SEAM(pb + 7 + 2 * ch));
                if (EN_MDN && IN(pb + 8 + 2 * ch)) PH(12, ph_moe_dn(j, ch); if (PROBE_MOE2) ph_moe_dn(j, ch); SEAM(pb + 8 + 2 * ch));
            }
            if (EN_ROUTE && IN(pb + 11)) PH(13, ph_combine(L); SEAM(pb + 11));
        }
    }
    if (PROBE_SPIN_MASK) { const unsigned long long t1_ = rt(); while (rt() - t1_ < probe_acc) __builtin_amdgcn_s_sleep(8); }
#undef IN
#undef SEAM
#undef PH
}

extern "C" void kernel_launch(void* const* d_in, const int* in_sizes, int n_in, void* d_out, int out_size, void* d_ws, size_t ws_size, hipStream_t stream) {
    static int grid = 0;
    if (grid == 0) {
        if (n_in != 30 || in_sizes[0] != M * DM || out_size != M * DM || ws_size < WS_END) {
            fprintf(stderr, "kernel_launch: unexpected shapes (n_in %d, in0 %d, out %d, ws %zu; need ws >= %zu); nothing launched\n", n_in, n_in > 0 ? in_sizes[0] : -1, out_size, ws_size, (size_t)WS_END); grid = -1; return; }
        int dev = 0, cus = 0, per_cu = 0;
        if (hipGetDevice(&dev) != hipSuccess || hipDeviceGetAttribute(&cus, hipDeviceAttributeMultiprocessorCount, dev) != hipSuccess) { grid = -1; return; }
        if (hipFuncSetAttribute((const void*)fwd_kernel, hipFuncAttributeMaxDynamicSharedMemorySize, LDS_BYTES) != hipSuccess) { fprintf(stderr, "kernel_launch: hipFuncSetAttribute failed\n"); grid = -1; return; }
        if (hipOccupancyMaxActiveBlocksPerMultiprocessor(&per_cu, (const void*)fwd_kernel, NWAVES * 64, LDS_BYTES) != hipSuccess || per_cu < 1) { fprintf(stderr, "kernel_launch: occupancy query says %d\n", per_cu); }
        (void)hipGetLastError();
        grid = cus;
    }
    if (grid < 0) return;
    (void)hipMemsetAsync((char*)d_ws, 0, ZERO_BYTES, stream);
    Args a{};
    for (int i = 0; i < 30; ++i) a.in[i] = (const float*)d_in[i];
    a.out = (float*)d_out; a.ws = (unsigned char*)d_ws;
#ifndef MK_ONE_LAUNCH
#define MK_ONE_LAUNCH 1
#endif
    if (MK_ONE_LAUNCH) { a.ph_lo = 0; a.ph_hi = N_PHASE_IDS; hipLaunchKernelGGL(fwd_kernel, dim3(grid), dim3(NWAVES * 64), LDS_BYTES, stream, a); }
    else {
        for (int p = 0; p < N_PHASE_IDS; ++p) {
            if (p > 0) { const int L = (p - 1) / 12, k = (p - 1) % 12; if ((L & 1) == 0 && k >= 9) continue; }
            a.ph_lo = p; a.ph_hi = p + 1;
            hipLaunchKernelGGL(fwd_kernel, dim3(grid), dim3(NWAVES * 64), LDS_BYTES, stream, a);
        }
    }
    const hipError_t le = hipPeekAtLastError();
    if (le != hipSuccess) fprintf(stderr, "kernel_launch: launch failed: %s\n", hipGetErrorName(le));
}
```

```cpp
#include <hip/hip_runtime.h>
#include <hip/hip_bf16.h>
#include <cstdio>
#include <cstdint>
#include <cmath>

constexpr int BATCH = 8, SEQ = 4096, DM = 1024, DEPTH = 4;
constexpr int M = BATCH * SEQ;
constexpr int SSM_W = 512, SSM_G = 32, SSM_GC = 16, SSM_P = 64;
constexpr int ATT_W = 512, ATT_H = 4, ATT_D = 64, ATT_DV = 128;
constexpr int IN_COLS = 2048;
constexpr int DFF = 2752, DFF_P = 2816;
constexpr int NEXP = 8, DFE = 3584;
constexpr float NORM_EPS = 1e-6f;
constexpr float QSCALE = 0.125f * 1.4426950408889634f;
constexpr float SS_FX = 16777216.0f, SS_FX_INV = 1.0f / 16777216.0f;

namespace pg8 {
#define PG8_LAS __attribute__((address_space(3)))
#define PG8_GAS __attribute__((address_space(1)))
typedef unsigned short bf16_t;
typedef short bf16x8 __attribute__((ext_vector_type(8)));
typedef float f32x4 __attribute__((ext_vector_type(4)));
typedef float f32x2 __attribute__((ext_vector_type(2)));
typedef unsigned u32x4 __attribute__((ext_vector_type(4)));
typedef unsigned u32x2 __attribute__((ext_vector_type(2)));
typedef int v4i32 __attribute__((ext_vector_type(4)));
constexpr int BM = 256, BK = 64, HALF = 128, HTB = HALF * BK * 2  , STAGE_BYTES = 8 * HTB, NXCD = 8, WGM = 8;

__host__ __device__ __forceinline__ int lds_byte(int r, int c) { const int st = (r >> 4) * 2 + (c >> 5), rr = r & 15, cc = c & 31, ob = rr * 64 + cc * 2; return st * 1024 + (ob ^ (((ob >> 9) & 1) << 5)); }
__host__ __device__ __forceinline__ void stage_rc(int b, int& R, int& C) { const int st = b / 1024, sb = b % 1024, swz = sb ^ (((sb >> 9) & 1) << 5); R = (st >> 1) * 16 + swz / 64; C = (st & 1) * 32 + (swz % 64) / 2; }
__host__ __device__ __forceinline__ int perm32(int rho) { const int n = rho >> 4, i = rho & 15; return 8 * (i >> 2) + 4 * n + (i & 3); }

struct Unit { int pm, pn, e; };
struct Gemm { const bf16_t* A; const bf16_t* Bt; int M, N, K; size_t be; };

struct StaticOrder {
    int nM, nN, nwg, G, c, rot;
    __host__ __device__ void init(int M_, int N_, int G_, int c_, int rot_ = 0) { nM = M_ / BM; nN = N_ / BM; nwg = nM * nN; G = G_; c = c_; rot = rot_; }
    __host__ __device__ bool next(int i, Unit& u) const {
        const long L = (long)i * G + c; if (L >= nwg) return false;
        int wgid = (int)L; { const int q = nwg / NXCD, r = nwg % NXCD, xcd = wgid % NXCD, off = wgid / NXCD; wgid = (xcd < r ? xcd * (q + 1) : r * (q + 1) + (xcd - r) * q) + off; }
        const int nig = WGM * nN, gid = wgid / nig, fm = gid * WGM, gsz = (nM - fm) < WGM ? (nM - fm) : WGM;
        u.pm = fm + ((wgid % nig) % gsz); u.pn = ((wgid % nig) / gsz + rot * gid) % nN; u.e = 0; return true;
    }
    __device__ __forceinline__ void a_ready(const Unit&) const {}
    __device__ __forceinline__ void done(const Unit&) const {}
};
struct ChunkOrder {
    int nM, nN, nwg, G, c, tlo; const PG8_LAS int* toff;
    __device__ bool next(int i, Unit& u) const {
        const long L = (long)i * G + c; if (L >= nwg) return false;
        int wgid = (int)L; { const int q = nwg / NXCD, r = nwg % NXCD, xcd = wgid % NXCD, off = wgid / NXCD; wgid = (xcd < r ? xcd * (q + 1) : r * (q + 1) + (xcd - r) * q) + off; }
        const int nig = WGM * nN, gid = wgid / nig, fm = gid * WGM, gsz = (nM - fm) < WGM ? (nM - fm) : WGM;
        u.pm = tlo + fm + ((wgid % nig) % gsz); u.pn = (wgid % nig) / gsz;
        int e = 0;
#pragma unroll
        for (int k = 1; k < 8; ++k) e += (u.pm >= toff[k]) ? 1 : 0;
        u.e = e; return true;
    }
    __device__ __forceinline__ void a_ready(const Unit&) const {}
    __device__ __forceinline__ void done(const Unit&) const {}
};

__device__ __forceinline__ unsigned cvt_pk_bf16(float lo, float hi) { unsigned r; asm volatile("v_cvt_pk_bf16_f32 %0, %1, %2" : "=v"(r) : "v"(lo), "v"(hi)); return r; }
__device__ __forceinline__ float bf_lo(unsigned w) { return __uint_as_float(w << 16); }
__device__ __forceinline__ float bf_hi(unsigned w) { return __uint_as_float(w & 0xffff0000u); }
__device__ __forceinline__ float rs_from_ss(const unsigned long long* ss, int row, float inv_n) {
    const unsigned long long v = *(const PG8_GAS unsigned long long*)(ss + row);
    return 1.0f / sqrtf((float)v * SS_FX_INV * inv_n + NORM_EPS);
}
__device__ __forceinline__ void rs8_from_ss(float (&rs)[8], const unsigned long long* ss, int row0, float inv_n) {
    if (ss) { unsigned long long v[8];
#pragma unroll
        for (int i = 0; i < 8; ++i) v[i] = *(const PG8_GAS unsigned long long*)(ss + row0 + (i >> 2) * HALF + (i & 3) * 16);
#pragma unroll
        for (int i = 0; i < 8; ++i) rs[i] = 1.0f / sqrtf((float)v[i] * SS_FX_INV * inv_n + NORM_EPS);
    } else {
#pragma unroll
        for (int i = 0; i < 8; ++i) rs[i] = 1.0f; }
}
__device__ __forceinline__ void ss_add(unsigned long long* ss, int row, float part) {
    __hip_atomic_fetch_add((PG8_GAS unsigned long long*)(ss + row), (unsigned long long)(part * SS_FX), __ATOMIC_RELAXED, __HIP_MEMORY_SCOPE_AGENT);
}
__device__ __forceinline__ float sum4sq(f32x4 v) { return (v[0] * v[0] + v[1] * v[1]) + (v[2] * v[2] + v[3] * v[3]); }
__device__ __forceinline__ f32x4 i32acc(f32x4 a) { const v4i32 v = __builtin_bit_cast(v4i32, a); return (f32x4){(float)v[0], (float)v[1], (float)v[2], (float)v[3]}; }

template <bool IACC>
struct EpiInProj {
    static constexpr bool PERM = true, AFTER_DRAIN = false;
    bf16_t* Ug; bf16_t* Q; size_t qkv_stride; const unsigned long long* ss; size_t vl_off, vr_off; unsigned* kmax; float descale;
    __device__ __forceinline__ void operator()(const f32x4 (&acc)[2][2][4][2], const Unit& u, int wr, int wc, int fr, int fq) const {
        const int row0 = u.pm * BM + wr * 64 + fr, ct = u.pn;
        float kmx[2] = {0.f, 0.f};
        float rs8[8]; if constexpr (IACC) {
#pragma unroll
            for (int i = 0; i < 8; ++i) rs8[i] = descale * ((ct == 2 || ct == 3) ? QSCALE : 1.0f); } else rs8_from_ss(rs8, ss, row0, 1.0f / DM);
#pragma unroll
        for (int ai = 0; ai < 2; ++ai)
#pragma unroll
            for (int m = 0; m < 4; ++m) { const int row = row0 + ai * HALF + m * 16; const float rs = rs8[ai * 4 + m];
#pragma unroll
                for (int bj = 0; bj < 2; ++bj) { const f32x4 v0 = (IACC ? i32acc(acc[ai][bj][m][0]) : acc[ai][bj][m][0]) * rs, v1 = (IACC ? i32acc(acc[ai][bj][m][1]) : acc[ai][bj][m][1]) * rs;
                    u32x4 w; w.x = cvt_pk_bf16(v0[0], v0[1]); w.y = cvt_pk_bf16(v0[2], v0[3]); w.z = cvt_pk_bf16(v1[0], v1[1]); w.w = cvt_pk_bf16(v1[2], v1[3]);
                    const int c0 = (ct & 1) * 256 + bj * HALF + wc * 32 + 8 * fq;
                    bf16_t* dst;
                    if (ct < 2) dst = Ug + ((size_t)(c0 >> 4) * M + row) * 16 + (c0 & 15);
                    else dst = Q + (size_t)((ct >> 1) - 1) * qkv_stride + (size_t)row * 512 + c0;
                    if (ct < 6) *(PG8_GAS u32x4*)dst = w;
                    if (ct >= 6) {
                        const int head = (ct & 1) * 2 + bj, kin = row & 63; const float sl2 = __builtin_amdgcn_exp2f(-2.0f * (float)(head + 1)) * 1.4426950408889634f;
                        const float wl = __builtin_amdgcn_exp2f(-sl2 * (float)(63 - kin)), wrr = __builtin_amdgcn_exp2f(-sl2 * (float)kin);
                        const f32x4 l0 = v0 * wl, l1 = v1 * wl, r0 = v0 * wrr, r1 = v1 * wrr;
                        u32x4 a; a.x = cvt_pk_bf16(l0[0], l0[1]); a.y = cvt_pk_bf16(l0[2], l0[3]); a.z = cvt_pk_bf16(l1[0], l1[1]); a.w = cvt_pk_bf16(l1[2], l1[3]);
                        u32x4 c; c.x = cvt_pk_bf16(r0[0], r0[1]); c.y = cvt_pk_bf16(r0[2], r0[3]); c.z = cvt_pk_bf16(r1[0], r1[1]); c.w = cvt_pk_bf16(r1[2], r1[3]);
                        *(PG8_GAS u32x4*)(dst + vl_off) = a; *(PG8_GAS u32x4*)(dst + vr_off) = c;
                    } else if (ct >= 4) {
                        float s = sum4sq(v0) + sum4sq(v1); s += __shfl_xor(s, 16); s += __shfl_xor(s, 32); kmx[bj] = fmaxf(kmx[bj], s);
                    } }
                asm volatile("" ::: "memory"); }
        if (ct >= 4 && ct < 6) {
#pragma unroll
            for (int bj = 0; bj < 2; ++bj) { float s = kmx[bj]; s = fmaxf(s, __shfl_xor(s, 1)); s = fmaxf(s, __shfl_xor(s, 2)); s = fmaxf(s, __shfl_xor(s, 4)); s = fmaxf(s, __shfl_xor(s, 8));
                const int head = (ct & 1) * 2 + bj, b = (u.pm * BM) / SEQ;
                if (fr == 0 && fq == 0) __hip_atomic_fetch_max(kmax + ((b * 4 + head) * 2 + (wc >> 1)) * 2 + (wc & 1), __float_as_uint(s * 1.02f), __ATOMIC_RELAXED, __HIP_MEMORY_SCOPE_AGENT); }
        }
    }
};
struct EpiGLU {
    static constexpr bool PERM = true, AFTER_DRAIN = false;
    const bf16_t* Y; bf16_t* MIX; const float* bias; unsigned long long* ss;
    __device__ __forceinline__ void operator()(const f32x4 (&acc)[2][2][4][2], const Unit& u, int wr, int wc, int fr, int fq) const {
        const int row0 = u.pm * BM + wr * 64 + fr; const int colb = u.pn * BM + wc * 32 + 8 * fq;
        f32x4 bv[2][2];
#pragma unroll
        for (int bj = 0; bj < 2; ++bj) { bv[bj][0] = *(const PG8_GAS f32x4*)(bias + colb + bj * HALF) * -1.4426950408889634f; bv[bj][1] = *(const PG8_GAS f32x4*)(bias + colb + bj * HALF + 4) * -1.4426950408889634f; }
        u32x4 ya[4][2];
#pragma unroll
        for (int g = 0; g < 4; ++g)
#pragma unroll
            for (int bj = 0; bj < 2; ++bj) ya[g][bj] = *(const PG8_GAS u32x4*)(Y + (size_t)(row0 + g * 16) * 512 + colb + bj * HALF);
#pragma unroll
        for (int g = 0; g < 8; ++g) { const int ai = g >> 2, m = g & 3; const int row = row0 + ai * HALF + m * 16; float part = 0.f;
#pragma unroll
            for (int bj = 0; bj < 2; ++bj) { const u32x4 yw = ya[g & 3][bj];
                if (g < 4) ya[g][bj] = *(const PG8_GAS u32x4*)(Y + (size_t)(row + HALF) * 512 + colb + bj * HALF);
                const f32x4 y0 = {bf_lo(yw.x), bf_hi(yw.x), bf_lo(yw.y), bf_hi(yw.y)}, y1 = {bf_lo(yw.z), bf_hi(yw.z), bf_lo(yw.w), bf_hi(yw.w)};
                const f32x4 a0 = acc[ai][bj][m][0], a1 = acc[ai][bj][m][1]; f32x4 o0, o1;
#pragma unroll
                for (int e = 0; e < 4; ++e) { o0[e] = y0[e] * __builtin_amdgcn_rcpf(1.0f + __builtin_amdgcn_exp2f(fmaf(a0[e], -1.4426950408889634f, bv[bj][0][e])));
                                              o1[e] = y1[e] * __builtin_amdgcn_rcpf(1.0f + __builtin_amdgcn_exp2f(fmaf(a1[e], -1.4426950408889634f, bv[bj][1][e]))); }
                part += sum4sq(o0) + sum4sq(o1);
                u32x4 w; w.x = cvt_pk_bf16(o0[0], o0[1]); w.y = cvt_pk_bf16(o0[2], o0[3]); w.z = cvt_pk_bf16(o1[0], o1[1]); w.w = cvt_pk_bf16(o1[2], o1[3]);
                *(PG8_GAS u32x4*)(MIX + (size_t)row * DM + colb + bj * HALF) = w; }
            part += __shfl_xor(part, 16); part += __shfl_xor(part, 32);
            if (fq == 0) ss_add(ss, row, part);
            asm volatile("" ::: "memory"); }
    }
};
template <bool IACC>
struct EpiResid {
    static constexpr bool PERM = true, AFTER_DRAIN = false;
    bf16_t* XB; const unsigned long long* ss_scale; float inv_n_scale; unsigned long long* ss_out; float descale;
    __device__ __forceinline__ void operator()(const f32x4 (&acc)[2][2][4][2], const Unit& u, int wr, int wc, int fr, int fq) const {
        const int row0 = u.pm * BM + wr * 64 + fr; const int colb = u.pn * BM + wc * 32 + 8 * fq;
        u32x4 xa[4][2];
#pragma unroll
        for (int g = 0; g < 4; ++g)
#pragma unroll
            for (int bj = 0; bj < 2; ++bj) xa[g][bj] = *(const PG8_GAS u32x4*)(XB + (size_t)(row0 + g * 16) * DM + colb + bj * HALF);
        float rs8[8]; rs8_from_ss(rs8, ss_scale, row0, inv_n_scale);
#pragma unroll
        for (int g = 0; g < 8; ++g) { const int ai = g >> 2, m = g & 3; const int row = row0 + ai * HALF + m * 16; const float rs = rs8[g]; float part = 0.f;
#pragma unroll
            for (int bj = 0; bj < 2; ++bj) { const u32x4 xw = xa[g & 3][bj];
                if (g < 4) xa[g][bj] = *(const PG8_GAS u32x4*)(XB + (size_t)(row + HALF) * DM + colb + bj * HALF);
                const f32x4 xo0 = {bf_lo(xw.x), bf_hi(xw.x), bf_lo(xw.y), bf_hi(xw.y)}, xo1 = {bf_lo(xw.z), bf_hi(xw.z), bf_lo(xw.w), bf_hi(xw.w)};
                const f32x4 xn0 = xo0 + (IACC ? i32acc(acc[ai][bj][m][0]) * descale : acc[ai][bj][m][0]) * rs, xn1 = xo1 + (IACC ? i32acc(acc[ai][bj][m][1]) * descale : acc[ai][bj][m][1]) * rs;
                part += sum4sq(xn0) + sum4sq(xn1);
                u32x4 w; w.x = cvt_pk_bf16(xn0[0], xn0[1]); w.y = cvt_pk_bf16(xn0[2], xn0[3]); w.z = cvt_pk_bf16(xn1[0], xn1[1]); w.w = cvt_pk_bf16(xn1[2], xn1[3]);
                *(PG8_GAS u32x4*)(XB + (size_t)row * DM + colb + bj * HALF) = w; }
            part += __shfl_xor(part, 16); part += __shfl_xor(part, 32);
            if (fq == 0) ss_add(ss_out, row, part);
            asm volatile("" ::: "memory"); }
    }
};
struct EpiGateUp {
    static constexpr bool PERM = true, AFTER_DRAIN = false;
    bf16_t* H; int ldh; const unsigned long long* ss;
    __device__ __forceinline__ void operator()(const f32x4 (&acc)[2][2][4][2], const Unit& u, int wr, int wc, int fr, int fq) const {
        const int row0 = u.pm * BM + wr * 64 + fr;
        float rs8[8]; rs8_from_ss(rs8, ss, row0, 1.0f / DM);
#pragma unroll
        for (int ai = 0; ai < 2; ++ai)
#pragma unroll
            for (int m = 0; m < 4; ++m) { const int row = row0 + ai * HALF + m * 16; const float rs = rs8[ai * 4 + m];
                f32x4 h[2];
#pragma unroll
                for (int n = 0; n < 2; ++n) { const f32x4 g = acc[ai][0][m][n] * rs, up = acc[ai][1][m][n] * rs;
#pragma unroll
                    for (int e = 0; e < 4; ++e) h[n][e] = g[e] * __builtin_amdgcn_rcpf(1.0f + __builtin_amdgcn_exp2f(-1.4426950408889634f * g[e])) * up[e]; }
                u32x4 w; w.x = cvt_pk_bf16(h[0][0], h[0][1]); w.y = cvt_pk_bf16(h[0][2], h[0][3]); w.z = cvt_pk_bf16(h[1][0], h[1][1]); w.w = cvt_pk_bf16(h[1][2], h[1][3]);
                *(PG8_GAS u32x4*)(H + (size_t)row * ldh + u.pn * HALF + wc * 32 + 8 * fq) = w;
                asm volatile("" ::: "memory"); }
    }
};
__device__ __forceinline__ unsigned pk4_i8(float a, float b, float c, float d) {
    unsigned w = 0; w = __builtin_amdgcn_cvt_pk_u8_f32(__builtin_rintf(a) + 128.f, 0, w); w = __builtin_amdgcn_cvt_pk_u8_f32(__builtin_rintf(b) + 128.f, 1, w);
    w = __builtin_amdgcn_cvt_pk_u8_f32(__builtin_rintf(c) + 128.f, 2, w); w = __builtin_amdgcn_cvt_pk_u8_f32(__builtin_rintf(d) + 128.f, 3, w); return w ^ 0x80808080u; }
__device__ __forceinline__ unsigned pk4_i8b(float a, float b, float c, float d) {
    unsigned w = 0; w = __builtin_amdgcn_cvt_pk_u8_f32(__builtin_rintf(a), 0, w); w = __builtin_amdgcn_cvt_pk_u8_f32(__builtin_rintf(b), 1, w);
    w = __builtin_amdgcn_cvt_pk_u8_f32(__builtin_rintf(c), 2, w); w = __builtin_amdgcn_cvt_pk_u8_f32(__builtin_rintf(d), 3, w); return w ^ 0x80808080u; }
template <bool OUT8>
struct EpiGateUp8 {
    static constexpr bool PERM = true, AFTER_DRAIN = false;
    unsigned char* H; int ldh; float descale, hscale;
    __device__ __forceinline__ void operator()(const f32x4 (&acc)[2][2][4][2], const Unit& u, int wr, int wc, int fr, int fq) const {
        const int row0 = u.pm * BM + wr * 64 + fr;
        const float C = descale * descale * hscale, ea = -1.4426950408889634f * descale, eb = -__builtin_amdgcn_logf(C), c0 = 1.0f / C;
#pragma unroll
        for (int ai = 0; ai < 2; ++ai)
#pragma unroll
            for (int m = 0; m < 4; ++m) { const int row = row0 + ai * HALF + m * 16;
                f32x4 h[2];
#pragma unroll
                for (int n = 0; n < 2; ++n) { const f32x4 g = i32acc(acc[ai][0][m][n]), up = i32acc(acc[ai][1][m][n]);
#pragma unroll
                    for (int e = 0; e < 4; ++e) { const float r = __builtin_amdgcn_rcpf(c0 + __builtin_amdgcn_exp2f(fmaf(g[e], ea, eb)));
                        h[n][e] = OUT8 ? fmaf(g[e] * up[e], r, 128.0f) : (g[e] * up[e]) * r; } }
                if constexpr (OUT8) { u32x2 w; w.x = pk4_i8b(h[0][0], h[0][1], h[0][2], h[0][3]); w.y = pk4_i8b(h[1][0], h[1][1], h[1][2], h[1][3]);
                    *(PG8_GAS u32x2*)(H + (size_t)row * ldh + u.pn * HALF + wc * 32 + 8 * fq) = w; }
                else { u32x4 w; w.x = cvt_pk_bf16(h[0][0], h[0][1]); w.y = cvt_pk_bf16(h[0][2], h[0][3]); w.z = cvt_pk_bf16(h[1][0], h[1][1]); w.w = cvt_pk_bf16(h[1][2], h[1][3]);
                    *(PG8_GAS u32x4*)((bf16_t*)H + (size_t)row * ldh + u.pn * HALF + wc * 32 + 8 * fq) = w; }
                asm volatile("" ::: "memory"); }
    }
};
template <bool IACC>
struct EpiStoreBf16 {
    static constexpr bool PERM = true, AFTER_DRAIN = false;
    bf16_t* O; int ldc; float scale;
    __device__ __forceinline__ void operator()(const f32x4 (&acc)[2][2][4][2], const Unit& u, int wr, int wc, int fr, int fq) const {
        const int row0 = u.pm * BM + wr * 64 + fr;
#pragma unroll
        for (int ai = 0; ai < 2; ++ai)
#pragma unroll
            for (int m = 0; m < 4; ++m) { bf16_t* rowp = O + (size_t)(row0 + ai * HALF + m * 16) * ldc + u.pn * BM + wc * 32 + 8 * fq;
#pragma unroll
                for (int bj = 0; bj < 2; ++bj) { const f32x4 v0 = (IACC ? i32acc(acc[ai][bj][m][0]) : acc[ai][bj][m][0]) * scale, v1 = (IACC ? i32acc(acc[ai][bj][m][1]) : acc[ai][bj][m][1]) * scale;
                    u32x4 w; w.x = cvt_pk_bf16(v0[0], v0[1]); w.y = cvt_pk_bf16(v0[2], v0[3]); w.z = cvt_pk_bf16(v1[0], v1[1]); w.w = cvt_pk_bf16(v1[2], v1[3]);
                    *(PG8_GAS u32x4*)(rowp + bj * HALF) = w; } }
    }
};

template <class Epi, class Sched, bool ALIGN_EPI = false, bool SP2 = false, int ESZ = 2  >
__device__ __forceinline__ void gemm_phase(PG8_LAS unsigned char* lds, const Gemm g, const Sched& S, const Epi& E) {
    int tid_ = threadIdx.x; asm volatile("" : "+v"(tid_));
    const int tid = tid_, wid = __builtin_amdgcn_readfirstlane(tid >> 6), lane = tid & 63, wr = wid >> 2, wc = wid & 3, fr = lane & 15, fq = lane >> 4;
    const int K = g.K * ESZ / 2  , nt = K / BK;
    unsigned voffA[2], voffB[2];
#pragma unroll
    for (int i = 0; i < 2; ++i) { int R, C; stage_rc(tid * 16 + i * 8192, R, C); const int Rb = Epi::PERM ? ((R & ~31) + perm32(R & 31)) : R;
        voffA[i] = (unsigned)(R * K + C) * 2u; voffB[i] = (unsigned)(Rb * K + C) * 2u; }
    const size_t kstep = (size_t)(BK * 2);
    const size_t hstep = (size_t)HALF * K * 2;
    const size_t tstep = 2 * hstep;
    const unsigned ldsw = (unsigned)wid * 1024u;
    const int aoff = lds_byte(wr * 64 + fr, fq * 8), boff = lds_byte(wc * 32 + fr, fq * 8);
#define PG8_SA(b, h) (((b) * 2 + (h)) * HTB)
#define PG8_SB(b, h) ((4 + (b) * 2 + (h)) * HTB)
#define PG8_STAGE(bufoff, gbase, voff) do { _Pragma("unroll") for (int _i = 0; _i < 2; ++_i) \
        __builtin_amdgcn_global_load_lds((const unsigned*)((const char*)(gbase) + (voff)[_i]), (PG8_LAS unsigned*)(lds + (bufoff) + ldsw + _i * 8192), 16, 0, 0); } while (0)
#define PG8_LDA(dst, b, h) do { _Pragma("unroll") for (int m = 0; m < 4; ++m) _Pragma("unroll") for (int k = 0; k < 2; ++k) dst[m][k] = *(const PG8_LAS bf16x8*)(lds + PG8_SA(b, h) + aoff + m * 2048 + k * 1024); } while (0)
#define PG8_LDB(dst, b, h) do { _Pragma("unroll") for (int n = 0; n < 2; ++n) _Pragma("unroll") for (int k = 0; k < 2; ++k) dst[n][k] = *(const PG8_LAS bf16x8*)(lds + PG8_SB(b, h) + boff + n * 2048 + k * 1024); } while (0)
#define PG8_MMA(ai, bj, At, Bt) do { __builtin_amdgcn_s_setprio(1); _Pragma("unroll") for (int m = 0; m < 4; ++m) _Pragma("unroll") for (int n = 0; n < 2; ++n) _Pragma("unroll") for (int k = 0; k < 2; ++k) { \
        if constexpr (ESZ == 2) acc[ai][bj][m][n] = __builtin_amdgcn_mfma_f32_16x16x32_bf16(Bt[n][k], At[m][k], acc[ai][bj][m][n], 0, 0, 0); \
        else acc[ai][bj][m][n] = __builtin_bit_cast(f32x4, __builtin_amdgcn_mfma_i32_16x16x64_i8(__builtin_bit_cast(v4i32, Bt[n][k]), __builtin_bit_cast(v4i32, At[m][k]), __builtin_bit_cast(v4i32, acc[ai][bj][m][n]), 0, 0, 0)); \
        } __builtin_amdgcn_s_setprio(0); } while (0)
#define PG8_WAIT_V(n) asm volatile("s_waitcnt vmcnt(" #n ")" ::: "memory")
#define PG8_WAIT_L(n) asm volatile("s_waitcnt lgkmcnt(" #n ")" ::: "memory")
#define PG8_BAR __builtin_amdgcn_s_barrier()
#define PG8_SCHED __builtin_amdgcn_sched_barrier(0)
    Unit cur, nxt; int ui = 0;
    if (!S.next(0, cur)) return;
    f32x4 acc[2][2][4][2];
#pragma unroll
    for (int a = 0; a < 2; ++a)
#pragma unroll
        for (int b = 0; b < 2; ++b)
#pragma unroll
            for (int m = 0; m < 4; ++m)
#pragma unroll
                for (int n = 0; n < 2; ++n) acc[a][b][m][n] = (f32x4){0.f, 0.f, 0.f, 0.f};
    bf16x8 At[4][2], B0[2][2], B1[2][2];
    const char* cA = (const char*)g.A + (size_t)cur.pm * tstep; const char* cB = (const char*)g.Bt + (size_t)cur.e * g.be + (size_t)cur.pn * tstep;
    S.a_ready(cur);
    if constexpr (SP2) {
        PG8_STAGE(PG8_SB(0, 0), cB, voffB); PG8_STAGE(PG8_SB(0, 1), cB + hstep, voffB); PG8_STAGE(PG8_SA(0, 0), cA, voffA); PG8_STAGE(PG8_SA(0, 1), cA + hstep, voffA);
        if (wr == 1) PG8_BAR;
        PG8_WAIT_V(2); PG8_BAR;
        PG8_STAGE(PG8_SB(1, 0), cB + kstep, voffB); PG8_STAGE(PG8_SA(1, 0), cA + kstep, voffA); PG8_STAGE(PG8_SB(1, 1), cB + hstep + kstep, voffB);
        PG8_WAIT_V(6); PG8_BAR;
    } else {
        PG8_STAGE(PG8_SB(0, 0), cB, voffB); PG8_STAGE(PG8_SA(0, 0), cA, voffA); PG8_STAGE(PG8_SB(0, 1), cB + hstep, voffB); PG8_STAGE(PG8_SA(0, 1), cA + hstep, voffA);
        if (wr == 1) PG8_BAR;
        PG8_WAIT_V(4); PG8_BAR;
        PG8_STAGE(PG8_SB(1, 0), cB + kstep, voffB); PG8_STAGE(PG8_SA(1, 0), cA + kstep, voffA); PG8_STAGE(PG8_SB(1, 1), cB + hstep + kstep, voffB);
        PG8_WAIT_V(6); PG8_BAR;
    }
    for (;;) {
        const bool has_next = S.next(ui + 1, nxt);
        const char* nA = has_next ? (const char*)g.A + (size_t)nxt.pm * tstep : cA; const char* nB = has_next ? (const char*)g.Bt + (size_t)nxt.e * g.be + (size_t)nxt.pn * tstep : cB;
#pragma unroll 1
        for (int t = 0; t < nt; t += 2) {
            const bool last = (t == nt - 2);
            const char* a1 = cA + (size_t)(t + 1) * kstep;
            const char* a2 = last ? nA : cA + (size_t)(t + 2) * kstep; const char* b2 = last ? nB : cB + (size_t)(t + 2) * kstep;
            const char* a3 = a2 + kstep; const char* b3 = b2 + kstep;
            if (last && has_next) S.a_ready(nxt);
            if constexpr (SP2) {
            PG8_LDB(B0, 0, 0); PG8_LDB(B1, 0, 1); PG8_SCHED; PG8_LDA(At, 0, 0); PG8_STAGE(PG8_SA(1, 1), a1 + hstep, voffA);
            PG8_WAIT_V(8); PG8_WAIT_L(0); PG8_BAR; PG8_MMA(0, 0, At, B0); PG8_MMA(0, 1, At, B1); PG8_BAR; PG8_SCHED;
            PG8_LDA(At, 0, 1); PG8_STAGE(PG8_SB(0, 0), b2, voffB); PG8_STAGE(PG8_SB(0, 1), b2 + hstep, voffB); PG8_STAGE(PG8_SA(0, 0), a2, voffA);
            PG8_WAIT_V(8); PG8_WAIT_L(0); PG8_BAR; PG8_MMA(1, 0, At, B0); PG8_MMA(1, 1, At, B1); PG8_BAR; PG8_SCHED;
            PG8_LDB(B0, 1, 0); PG8_LDB(B1, 1, 1); PG8_SCHED; PG8_LDA(At, 1, 0); PG8_STAGE(PG8_SA(0, 1), a2 + hstep, voffA);
            PG8_WAIT_V(8); PG8_WAIT_L(0); PG8_BAR; PG8_MMA(0, 0, At, B0); PG8_MMA(0, 1, At, B1); PG8_BAR; PG8_SCHED;
            PG8_LDA(At, 1, 1); PG8_STAGE(PG8_SB(1, 0), b3, voffB); PG8_STAGE(PG8_SB(1, 1), b3 + hstep, voffB); PG8_STAGE(PG8_SA(1, 0), a3, voffA);
            PG8_WAIT_V(8); PG8_WAIT_L(0); PG8_BAR; PG8_MMA(1, 0, At, B0); PG8_MMA(1, 1, At, B1); PG8_BAR; PG8_SCHED;
            } else {
            PG8_LDB(B0, 0, 0); PG8_SCHED; PG8_LDA(At, 0, 0); PG8_STAGE(PG8_SA(1, 1), a1 + hstep, voffA);
            PG8_WAIT_L(8); PG8_BAR; PG8_WAIT_L(0); PG8_MMA(0, 0, At, B0); PG8_BAR; PG8_SCHED;
            PG8_LDB(B1, 0, 1); PG8_STAGE(PG8_SB(0, 0), b2, voffB);
            PG8_BAR; PG8_WAIT_L(0); PG8_MMA(0, 1, At, B1); PG8_BAR;
            PG8_LDA(At, 0, 1); PG8_STAGE(PG8_SA(0, 0), a2, voffA);
            PG8_BAR; PG8_WAIT_L(0); PG8_MMA(1, 0, At, B0); PG8_BAR; PG8_SCHED;
            PG8_STAGE(PG8_SB(0, 1), b2 + hstep, voffB);
            PG8_WAIT_V(6); PG8_BAR; PG8_MMA(1, 1, At, B1); PG8_BAR;
            PG8_LDB(B0, 1, 0); PG8_SCHED; PG8_LDA(At, 1, 0); PG8_STAGE(PG8_SA(0, 1), a2 + hstep, voffA);
            PG8_WAIT_L(8); PG8_BAR; PG8_WAIT_L(0); PG8_MMA(0, 0, At, B0); PG8_BAR; PG8_SCHED;
            PG8_LDB(B1, 1, 1); PG8_STAGE(PG8_SB(1, 0), b3, voffB);
            PG8_BAR; PG8_WAIT_L(0); PG8_MMA(0, 1, At, B1); PG8_BAR;
            PG8_LDA(At, 1, 1); PG8_STAGE(PG8_SA(1, 0), a3, voffA);
            PG8_BAR; PG8_WAIT_L(0); PG8_MMA(1, 0, At, B0); PG8_BAR; PG8_SCHED;
            PG8_STAGE(PG8_SB(1, 1), b3 + hstep, voffB);
            PG8_WAIT_V(6); PG8_BAR; PG8_MMA(1, 1, At, B1); PG8_BAR;
            }
        }
        if constexpr (ALIGN_EPI) { if (wr == 0) PG8_BAR; }
        if constexpr (!Epi::AFTER_DRAIN) { E(acc, cur, wr, wc, fr, fq); S.done(cur); }
        if (!has_next) break;
#pragma unroll
        for (int a = 0; a < 2; ++a)
#pragma unroll
            for (int b = 0; b < 2; ++b)
#pragma unroll
                for (int m = 0; m < 4; ++m)
#pragma unroll
                    for (int n = 0; n < 2; ++n) acc[a][b][m][n] = (f32x4){0.f, 0.f, 0.f, 0.f};
        cur = nxt; cA = nA; cB = nB; ++ui;
        if constexpr (ALIGN_EPI) { if (wr == 1) PG8_BAR; }
    }
    PG8_WAIT_V(0);
    if constexpr (!ALIGN_EPI) { if (wr == 0) PG8_BAR; }
    PG8_BAR;
    if constexpr (Epi::AFTER_DRAIN) { E.fused(acc, cur, wr, wc, fr, fq, lds, wid, lane); S.done(cur); }
#undef PG8_SA
#undef PG8_SB
#undef PG8_STAGE
#undef PG8_LDA
#undef PG8_LDB
#undef PG8_MMA
#undef PG8_WAIT_V
#undef PG8_WAIT_L
#undef PG8_BAR
#undef PG8_SCHED
}
}


namespace att {
using bf16 = unsigned short;
using bf16x8 = __attribute__((ext_vector_type(8))) short;
using s16x4  = __attribute__((ext_vector_type(4))) short;
using f32x16 = __attribute__((ext_vector_type(16))) float;
using u32x4  = __attribute__((ext_vector_type(4))) unsigned;
constexpr int NW = 8, QBLK = 32, KVBLK = 64, LDQ = 512;
constexpr int SHM_V = KVBLK * 128 * 2, SHM_K = KVBLK * 64 * 2, SHM_ATTN = 2 * SHM_V + 2 * SHM_K + NW * 64 * 4;
constexpr float THR2 = 8.f;
#define ATT_KSWZ(row, colB) ((row) * 128 + ((colB) ^ ((((row) >> 1) & 7) << 4)))
#define ATT_SBAR() __builtin_amdgcn_sched_barrier(0)
__device__ __forceinline__ int crow(int r, int hi) { return (r & 3) + 8 * (r >> 2) + 4 * hi; }
__device__ __forceinline__ unsigned cvtpk(float lo, float hi) { unsigned r; asm volatile("v_cvt_pk_bf16_f32 %0, %1, %2" : "=v"(r) : "v"(lo), "v"(hi)); return r; }

typedef __attribute__((address_space(3))) char lchar;
typedef __attribute__((address_space(3))) float lfloat;
__device__ __forceinline__ void qkt(f32x16& p0, f32x16& p1, const lchar* Ks, const bf16x8* qr, int r32, int hi, const f32x16 seed = f32x16{}) {
  bf16x8 kf[8];
#pragma unroll
  for (int d0 = 0; d0 < 4; ++d0) { const int cb = (d0 * 16 + hi * 8) * 2;
    kf[2 * d0] = *(const __attribute__((address_space(3))) bf16x8*)(Ks + ATT_KSWZ(r32, cb));
    kf[2 * d0 + 1] = *(const __attribute__((address_space(3))) bf16x8*)(Ks + ATT_KSWZ(32 + r32, cb)); }
  asm volatile("s_waitcnt lgkmcnt(0)" ::: "memory"); ATT_SBAR();
  p0 = seed; p1 = seed;
#pragma unroll
  for (int d0 = 0; d0 < 4; ++d0) {
    p0 = __builtin_amdgcn_mfma_f32_32x32x16_bf16(kf[2 * d0], qr[d0], p0, 0, 0, 0);
    p1 = __builtin_amdgcn_mfma_f32_32x32x16_bf16(kf[2 * d0 + 1], qr[d0], p1, 0, 0, 0); }
}
__device__ __forceinline__ int v_st(int k, int c) { const int kk = (k & ~0xC) | ((k & 4) << 1) | ((k & 8) >> 1); return ((kk >> 3) * 4 + (c >> 5)) * 512 + ((kk & 7) * 32 + (c & 31)) * 2; }
__device__ __forceinline__ int v_rd_base(int lane) { return ((lane & 3) << 3) | (((lane >> 2) & 3) << 6) | (((lane >> 4) & 1) << 5) | (((lane >> 5) & 1) << 8); }
constexpr int v_rd_off(int d0, int ks, int half) { return d0 * 512 + ks * 4096 + half * 2048; }
template <int OFF> __device__ __forceinline__ s16x4 tr_read(int vb) {
  s16x4 r; asm volatile("ds_read_b64_tr_b16 %0, %1 offset:%2" : "=&v"(r) : "v"(vb), "i"(OFF) : "memory"); return r;
}
template <int D0> __device__ __forceinline__ void pv_one(f32x16& od, int vb, bf16x8 pa0, bf16x8 pa1, bf16x8 pa2, bf16x8 pa3) {
  const s16x4 l0 = tr_read<v_rd_off(D0, 0, 0)>(vb), h0 = tr_read<v_rd_off(D0, 0, 1)>(vb), l1 = tr_read<v_rd_off(D0, 1, 0)>(vb), h1 = tr_read<v_rd_off(D0, 1, 1)>(vb);
  const s16x4 l2 = tr_read<v_rd_off(D0, 2, 0)>(vb), h2 = tr_read<v_rd_off(D0, 2, 1)>(vb), l3 = tr_read<v_rd_off(D0, 3, 0)>(vb), h3 = tr_read<v_rd_off(D0, 3, 1)>(vb);
  asm volatile("s_waitcnt lgkmcnt(0)" ::: "memory"); ATT_SBAR();
#define ATT_PK(L, H) (bf16x8){L[0], L[1], L[2], L[3], H[0], H[1], H[2], H[3]}
  od = __builtin_amdgcn_mfma_f32_32x32x16_bf16(pa0, ATT_PK(l0, h0), od, 0, 0, 0);
  od = __builtin_amdgcn_mfma_f32_32x32x16_bf16(pa1, ATT_PK(l1, h1), od, 0, 0, 0);
  od = __builtin_amdgcn_mfma_f32_32x32x16_bf16(pa2, ATT_PK(l2, h2), od, 0, 0, 0);
  od = __builtin_amdgcn_mfma_f32_32x32x16_bf16(pa3, ATT_PK(l3, h3), od, 0, 0, 0);
#undef ATT_PK
}
__device__ __forceinline__ void pv_d0(f32x16* o, int vb, bf16x8 pa0, bf16x8 pa1, bf16x8 pa2, bf16x8 pa3) {
  pv_one<0>(o[0], vb, pa0, pa1, pa2, pa3); pv_one<1>(o[1], vb, pa0, pa1, pa2, pa3); pv_one<2>(o[2], vb, pa0, pa1, pa2, pa3); pv_one<3>(o[3], vb, pa0, pa1, pa2, pa3);
}

typedef __attribute__((address_space(1))) const bf16x8 gbf16x8;
struct Stage { bf16x8 v0, v1, k0; };
struct PassCtx {
  const bf16* Kh; const bf16* Vh; long vl_off, vr_off; lchar* V_lds; lchar* K_lds;
  int sr, sc, vst0, vst1, kr, kcB, kst, vb0, qpos, td0, td1, r32, hi, t_hi; unsigned offv, offk;
  float slope2, m_i, g1, g8, g32, i1, i8, i32, lfL, lfR;
};
__device__ __forceinline__ const char* uni_ptr(const void* p) {
  const unsigned long long v = (unsigned long long)(uintptr_t)p;
  const unsigned lo = (unsigned)__builtin_amdgcn_readfirstlane((int)(unsigned)v), hi = (unsigned)__builtin_amdgcn_readfirstlane((int)(unsigned)(v >> 32));
  return (const char*)(uintptr_t)(((unsigned long long)hi << 32) | lo);
}
__device__ __forceinline__ void st_load(Stage& s, const PassCtx& c, int t) {
  const long vo = t < c.td0 ? c.vl_off : c.vr_off; const long r0 = (long)t * KVBLK * LDQ;
  const char* bv = uni_ptr(c.Vh + vo + r0); const char* bk = uni_ptr(c.Kh + r0);
  s.v0 = *(gbf16x8*)(bv + c.offv); s.v1 = *(gbf16x8*)(bv + (size_t)32 * LDQ * 2 + c.offv);
  s.k0 = *(gbf16x8*)(bk + c.offk);
}
__device__ __forceinline__ void st_write(const Stage& s, const PassCtx& c, int b) {
  *(__attribute__((address_space(3))) bf16x8*)(c.V_lds + b * SHM_V + c.vst0) = s.v0; *(__attribute__((address_space(3))) bf16x8*)(c.V_lds + b * SHM_V + c.vst1) = s.v1;
  *(__attribute__((address_space(3))) bf16x8*)(c.K_lds + b * SHM_K + c.kst) = s.k0;
}
#define ATT_PK4(P, BASE, OUT) do { unsigned a0 = cvtpk(P[BASE + 0], P[BASE + 1]), a1 = cvtpk(P[BASE + 2], P[BASE + 3]);   \
    unsigned b0 = cvtpk(P[BASE + 4], P[BASE + 5]), b1 = cvtpk(P[BASE + 6], P[BASE + 7]);                              \
    auto r0 = __builtin_amdgcn_permlane32_swap(a0, b0, false, false); auto r1 = __builtin_amdgcn_permlane32_swap(a1, b1, false, false); \
    u32x4 w = {r0[0], r1[0], r0[1], r1[1]}; OUT = *reinterpret_cast<bf16x8*>(&w); } while (0)
__device__ __forceinline__ void att_rowsum(float& l_reg, const f32x16& p0, const f32x16& p1, float h1, float h8, float h32, float lf) {
  float u0, u1;
  { float t0 = fmaf(fmaf(fmaf(p0[3], h1, p0[2]), h1, p0[1]), h1, p0[0]), t1 = fmaf(fmaf(fmaf(p0[7], h1, p0[6]), h1, p0[5]), h1, p0[4]);
    float t2 = fmaf(fmaf(fmaf(p0[11], h1, p0[10]), h1, p0[9]), h1, p0[8]), t3 = fmaf(fmaf(fmaf(p0[15], h1, p0[14]), h1, p0[13]), h1, p0[12]);
    u0 = fmaf(fmaf(fmaf(t3, h8, t2), h8, t1), h8, t0); }
  { float t0 = fmaf(fmaf(fmaf(p1[3], h1, p1[2]), h1, p1[1]), h1, p1[0]), t1 = fmaf(fmaf(fmaf(p1[7], h1, p1[6]), h1, p1[5]), h1, p1[4]);
    float t2 = fmaf(fmaf(fmaf(p1[11], h1, p1[10]), h1, p1[9]), h1, p1[8]), t3 = fmaf(fmaf(fmaf(p1[15], h1, p1[14]), h1, p1[13]), h1, p1[12]);
    u1 = fmaf(fmaf(fmaf(t3, h8, t2), h8, t1), h8, t0); }
  l_reg = fmaf(fmaf(u1, h32, u0), lf, l_reg);
}
template <int B>
__device__ __forceinline__ void attn_tile(int j, int jn, const PassCtx& c, const bf16x8 (&qr)[4], f32x16 (&o)[4], float& l_reg, Stage& ld, const Stage& wr) {
  st_load(ld, c, jn);
  f32x16 p0, p1;
  float h1, h8, h32, lf;
  float cc;
  if (j < c.td0) {
    cc = -c.slope2 * (float)(c.qpos - j * KVBLK - 63) - c.m_i; h1 = c.g1; h8 = c.g8; h32 = c.g32; lf = c.lfL;
  } else {
    cc = -c.slope2 * (float)(j * KVBLK - c.qpos) - c.m_i; h1 = c.i1; h8 = c.i8; h32 = c.i32; lf = c.lfR;
  }
  { f32x16 seed;
#pragma unroll
    for (int r = 0; r < 16; ++r) seed[r] = cc;
    qkt(p0, p1, c.K_lds + B * SHM_K, qr, c.r32, c.hi, seed); }
#pragma unroll
  for (int r = 0; r < 16; ++r) { p0[r] = __builtin_amdgcn_exp2f(p0[r]); p1[r] = __builtin_amdgcn_exp2f(p1[r]); }
  att_rowsum(l_reg, p0, p1, h1, h8, h32, lf);
  bf16x8 pa0, pa1, pa2, pa3;
  ATT_PK4(p0, 0, pa0); ATT_PK4(p0, 8, pa1); ATT_PK4(p1, 0, pa2); ATT_PK4(p1, 8, pa3);
  ATT_SBAR();
  pv_d0(o, c.vb0 + B * SHM_V, pa0, pa1, pa2, pa3);
  asm volatile("s_waitcnt lgkmcnt(0)\n\ts_barrier" ::: "memory");
  st_write(wr, c, B);
}
__device__ __forceinline__ void attn_diag_tile(int t, const PassCtx& c, const bf16x8 (&qr)[4], f32x16 (&o)[4], float& l_reg, const lchar* Kd, int vbd, const f32x16& sd0, const f32x16& sd1) {
  f32x16 p0, p1;
  { bf16x8 kf[8];
#pragma unroll
    for (int d0 = 0; d0 < 4; ++d0) { const int cb = (d0 * 16 + c.hi * 8) * 2;
      kf[2 * d0] = *(const __attribute__((address_space(3))) bf16x8*)(Kd + ATT_KSWZ(c.r32, cb));
      kf[2 * d0 + 1] = *(const __attribute__((address_space(3))) bf16x8*)(Kd + ATT_KSWZ(32 + c.r32, cb)); }
    asm volatile("s_waitcnt lgkmcnt(0)" ::: "memory"); ATT_SBAR();
    p0 = sd0; p1 = sd1;
#pragma unroll
    for (int d0 = 0; d0 < 4; ++d0) {
      p0 = __builtin_amdgcn_mfma_f32_32x32x16_bf16(kf[2 * d0], qr[d0], p0, 0, 0, 0);
      p1 = __builtin_amdgcn_mfma_f32_32x32x16_bf16(kf[2 * d0 + 1], qr[d0], p1, 0, 0, 0); } }
  float dq = (float)(c.qpos - (c.td0 + t) * KVBLK - 4 * c.hi); asm volatile("" : "+v"(dq));
#pragma unroll
  for (int r = 0; r < 16; ++r) { const float cc = (float)((r & 3) + 8 * (r >> 2));
    p0[r] = __builtin_amdgcn_exp2f(fmaf(-c.slope2, fabsf(dq - cc), p0[r])); p1[r] = __builtin_amdgcn_exp2f(fmaf(-c.slope2, fabsf(dq - (cc + 32.f)), p1[r])); }
  att_rowsum(l_reg, p0, p1, c.i1, c.i8, c.i32, c.lfR);
  bf16x8 pa0, pa1, pa2, pa3;
  ATT_PK4(p0, 0, pa0); ATT_PK4(p0, 8, pa1); ATT_PK4(p1, 0, pa2); ATT_PK4(p1, 8, pa3);
  ATT_SBAR();
  pv_d0(o, vbd, pa0, pa1, pa2, pa3);
}
__device__ __forceinline__ void attn_pass(const bf16* Qw, const bf16* Kh, const bf16* Vh, long vl_off, long vr_off, int qb, float slope2, float k2max  , lchar* lds, f32x16 (&o)[4], float& l_out) {
  int tid_ = threadIdx.x; asm volatile("" : "+v"(tid_));
  const int tid = tid_, wid = tid >> 6, lane = tid & 63;
  PassCtx c;
  c.r32 = lane & 31; c.hi = lane >> 5; c.Kh = Kh; c.Vh = Vh; c.vl_off = vl_off; c.vr_off = vr_off; c.V_lds = lds; c.K_lds = lds + 2 * SHM_V; c.slope2 = slope2;
  c.sr = tid >> 4; c.sc = (tid & 15) * 8; c.vst0 = v_st(c.sr, c.sc); c.vst1 = v_st(32 + c.sr, c.sc);
  c.kr = tid >> 3; c.kcB = (tid & 7) * 16; c.kst = ATT_KSWZ(c.kr, c.kcB);
  c.offv = (unsigned)((c.sr * LDQ + c.sc) * 2); c.offk = (unsigned)(c.kr * LDQ * 2 + c.kcB);
  c.vb0 = (int)(unsigned)(uintptr_t)c.V_lds + v_rd_base(lane);
  c.qpos = qb * 256 + wid * QBLK + c.r32; c.td0 = 4 * qb; c.td1 = 4 * qb + 3;
  c.g1 = __builtin_amdgcn_exp2f(slope2); c.g8 = __builtin_amdgcn_exp2f(8.f * slope2); c.g32 = __builtin_amdgcn_exp2f(32.f * slope2);
  c.i1 = __builtin_amdgcn_exp2f(-slope2); c.i8 = __builtin_amdgcn_exp2f(-8.f * slope2); c.i32 = __builtin_amdgcn_exp2f(-32.f * slope2);
  c.lfL = __builtin_amdgcn_exp2f(slope2 * (float)(4 * c.hi - 63)); c.lfR = __builtin_amdgcn_exp2f(-slope2 * (float)(4 * c.hi));
  float l_reg = 0;
#pragma unroll
  for (int d = 0; d < 4; ++d) o[d] = f32x16{};
  bf16x8 qr[4];
#pragma unroll
  for (int d0 = 0; d0 < 4; ++d0) qr[d0] = *(gbf16x8*)(Qw + (long)c.r32 * LDQ + d0 * 16 + c.hi * 8);
  float m_i, ex;
  { float s = 0.f;
#pragma unroll
    for (int d0 = 0; d0 < 4; ++d0) { const u32x4 w = __builtin_bit_cast(u32x4, qr[d0]);
      const float a0 = __uint_as_float(w.x << 16), a1 = __uint_as_float(w.x & 0xffff0000u), a2 = __uint_as_float(w.y << 16), a3 = __uint_as_float(w.y & 0xffff0000u);
      const float a4 = __uint_as_float(w.z << 16), a5 = __uint_as_float(w.z & 0xffff0000u), a6 = __uint_as_float(w.w << 16), a7 = __uint_as_float(w.w & 0xffff0000u);
      s += (a0 * a0 + a1 * a1) + (a2 * a2 + a3 * a3) + (a4 * a4 + a5 * a5) + (a6 * a6 + a7 * a7); }
    { auto rr = __builtin_amdgcn_permlane32_swap(__float_as_uint(s), __float_as_uint(s), false, false); s = __uint_as_float(rr[0]) + __uint_as_float(rr[1]); }
    const float m_bound = sqrtf(s * k2max) * 1.01f + 0.01f; m_i = fminf(m_bound, 64.0f); ex = m_bound - m_i; }
  c.m_i = m_i;
  int t_lo, t_hi;
  { lchar* Kd = lds + 4 * SHM_V; lchar* Vd = lds;
    { const bf16* kp = Kh + (long)(c.td0 * KVBLK + c.kr) * LDQ + (c.kcB >> 1); const bf16* vp = Vh + vr_off + (long)(c.td0 * KVBLK + c.sr) * LDQ + c.sc;
      bf16x8 k4[4], v4a[4], v4b[4];
#pragma unroll
      for (int t = 0; t < 4; ++t) { k4[t] = *(gbf16x8*)(kp + (long)t * KVBLK * LDQ); v4a[t] = *(gbf16x8*)(vp + (long)t * KVBLK * LDQ); v4b[t] = *(gbf16x8*)(vp + (long)(t * KVBLK + 32) * LDQ); }
#pragma unroll
      for (int t = 0; t < 4; ++t) { *(__attribute__((address_space(3))) bf16x8*)(Kd + t * SHM_K + c.kst) = k4[t];
        *(__attribute__((address_space(3))) bf16x8*)(Vd + t * SHM_V + c.vst0) = v4a[t]; *(__attribute__((address_space(3))) bf16x8*)(Vd + t * SHM_V + c.vst1) = v4b[t]; } }
    asm volatile("s_waitcnt lgkmcnt(0)" ::: "memory"); __syncthreads();
    { f32x16 sd0, sd1;
#pragma unroll
      for (int r = 0; r < 16; ++r) { sd0[r] = fmaf(c.slope2, (float)((r & 3) + 8 * (r >> 2) + 4 * c.hi), -c.m_i); sd1[r] = fmaf(c.slope2, (float)((r & 3) + 8 * (r >> 2) + 4 * c.hi + 32), -c.m_i); }
#pragma unroll 1
      for (int t = 0; t < 4; ++t) attn_diag_tile(t, c, qr, o, l_reg, Kd + t * SHM_K, c.vb0 + t * SHM_V, sd0, sd1); }
    float lp;
    { auto rr = __builtin_amdgcn_permlane32_swap(__float_as_uint(l_reg), __float_as_uint(l_reg), false, false); lp = (__uint_as_float(rr[0]) + __uint_as_float(rr[1])) * __builtin_amdgcn_exp2f(-ex); }
#pragma unroll
    for (int o_ = 1; o_ < 32; o_ <<= 1) lp = fminf(lp, __shfl_xor(lp, o_));
    lfloat* wsred = (lfloat*)(lds + 4 * SHM_V + 4 * SHM_K);
    if (lane == 0) wsred[wid] = lp;
    asm volatile("s_waitcnt lgkmcnt(0)" ::: "memory"); __syncthreads();
    float lmin = wsred[0];
#pragma unroll
    for (int w = 1; w < 8; ++w) lmin = fminf(lmin, wsred[w]);
    lmin = __uint_as_float(__builtin_amdgcn_readfirstlane(__float_as_uint(lmin)));
    const float dist = (24.0f - __builtin_amdgcn_logf(fmaxf(lmin, 1e-37f))) / slope2;
    const int D = dist >= 8192.f ? 8192 : (int)dist + 1, q0 = qb * 256;
    const int klo = q0 - D, khi = q0 + 255 + D; t_lo = klo <= 0 ? 0 : (klo >> 6); t_hi = khi >= SEQ - 1 ? (SEQ / 64 - 1) : (khi >> 6); }
  const int nl = c.td0 - t_lo, n = nl + (t_hi - c.td1);
  c.t_hi = t_hi;
  if (n > 0) {
#define ATT_TILE_OF(s_) ({ int s__ = (s_) < n - 1 ? (s_) : n - 1; s__ < nl ? t_lo + s__ : c.td1 + 1 + (s__ - nl); })
    Stage sA, sB;
    st_load(sA, c, ATT_TILE_OF(0)); st_write(sA, c, 0); st_load(sB, c, ATT_TILE_OF(1)); st_write(sB, c, 1);
    st_load(sA, c, ATT_TILE_OF(2));
    __syncthreads();
#pragma unroll 1
    for (int s = 0; s < n; s += 2) {
      attn_tile<0>(ATT_TILE_OF(s), ATT_TILE_OF(s + 3), c, qr, o, l_reg, sB, sA);
      if (s + 1 < n) attn_tile<1>(ATT_TILE_OF(s + 1), ATT_TILE_OF(s + 4), c, qr, o, l_reg, sA, sB);
    }
#undef ATT_TILE_OF
  }
  { auto rr = __builtin_amdgcn_permlane32_swap(__float_as_uint(l_reg), __float_as_uint(l_reg), false, false); l_out = __uint_as_float(rr[0]) + __uint_as_float(rr[1]); }
  __syncthreads();
}
#undef ATT_PK4
}


#define GAS __attribute__((address_space(1)))
#define LAS __attribute__((address_space(3)))
typedef unsigned short bf16;
typedef unsigned v4u __attribute__((ext_vector_type(4)));
typedef float f32x4 __attribute__((ext_vector_type(4)));
typedef short bf16x8 __attribute__((ext_vector_type(8)));
typedef GAS unsigned gu32;
typedef GAS unsigned long long gu64;
#define RLX_AGENT __ATOMIC_RELAXED, __HIP_MEMORY_SCOPE_AGENT
#define LDS_WAIT() asm volatile("s_waitcnt lgkmcnt(0)" ::: "memory")
#define VM_WAIT() asm volatile("s_waitcnt vmcnt(0)" ::: "memory")
__device__ __forceinline__ unsigned long long rt() { return __builtin_amdgcn_s_memrealtime(); }
__device__ __forceinline__ unsigned f2bf(float f) { unsigned u = __builtin_bit_cast(unsigned, f); return (u + 0x7fffu + ((u >> 16) & 1u)) >> 16; }
__device__ __forceinline__ unsigned pk2(float lo, float hi) { return f2bf(lo) | (f2bf(hi) << 16); }

#define XB_TMO      128
#define XB_XCNT(j)  (256  + 64 * (j))
#define XB_XSUB(j)  (1280 + 64 * (j))
#define XB_XGEN(j)  (2304 + 64 * (j))
#define XB_TOP      3328
#define XB_TOPGEN   3392
#define XCD_BAR_WORDS 3456
#define XB_SPIN_CAP (1u << 18)

__device__ __forceinline__ unsigned xb_ld(unsigned* p)              { return __hip_atomic_load(p, __ATOMIC_RELAXED, __HIP_MEMORY_SCOPE_AGENT); }
__device__ __forceinline__ unsigned xb_add(unsigned* p, unsigned v) { return __hip_atomic_fetch_add(p, v, __ATOMIC_RELAXED, __HIP_MEMORY_SCOPE_AGENT); }
__device__ __forceinline__ unsigned xb_xcc_id() { return (unsigned)__builtin_amdgcn_s_getreg((3 << 11) | 20) & 0xFu; }
#define XB_SPIN(cond, bar) do { unsigned _sp = 0; while (cond) { __builtin_amdgcn_s_sleep(1); \
    if ((++_sp & 255u) == 0u) { if (xb_ld(&(bar)[XB_TMO])) break; if (_sp > XB_SPIN_CAP) { atomicAdd(&(bar)[XB_TMO], 1u); break; } } } } while (0)

struct XcdBarrier {
    unsigned* bar; unsigned x;
    volatile LAS unsigned* st;
};

__device__ __forceinline__ XcdBarrier xcd_barrier_post(unsigned* bar, volatile LAS unsigned* st) {
    XcdBarrier b; b.bar = bar; b.x = xb_xcc_id(); b.st = st;
    if (threadIdx.x == 0) (void)xb_add(&bar[XB_XCNT(b.x)], 1u);
    return b;
}
__device__ __forceinline__ void xcd_barrier_complete(unsigned* bar, unsigned x, unsigned& nloc, unsigned& nx) {
    const unsigned G = gridDim.x * gridDim.y * gridDim.z;
    unsigned sum, cnt, mine, sp = 0u;
    for (;;) {
        sum = 0u; cnt = 0u; mine = 0u;
#pragma unroll
        for (unsigned j = 0; j < 16; ++j) { const unsigned c = xb_ld(&bar[XB_XCNT(j)]); sum += c; cnt += (c > 0u) ? 1u : 0u; mine = (j == x) ? c : mine; }
        if (sum == G) break;
        __builtin_amdgcn_s_sleep(1);
        if ((++sp & 255u) == 0u) { if (xb_ld(&bar[XB_TMO])) break; if (sp > XB_SPIN_CAP) { atomicAdd(&bar[XB_TMO], 1u); break; } }
    }
    nloc = mine > 0u ? mine : 1u; nx = cnt > 0u ? cnt : 1u;
}

__device__ __forceinline__ void xcd_barrier(const XcdBarrier& b) {
    asm volatile("s_waitcnt vmcnt(0)" ::: "memory");
    __syncthreads();
    if (threadIdx.x == 0) {
        unsigned* bar = b.bar;
        __builtin_amdgcn_s_waitcnt(0);
        unsigned nloc = b.st[0], nx = b.st[1];
        if (nloc == 0u) { xcd_barrier_complete(bar, b.x, nloc, nx); b.st[0] = nloc; b.st[1] = nx; }
        const unsigned old = xb_add(&bar[XB_XSUB(b.x)], 1u);
        const unsigned gen = old / nloc;
        if (old + 1u == (gen + 1u) * nloc) {
            __builtin_amdgcn_fence(__ATOMIC_RELEASE, "agent");
            asm volatile("s_waitcnt vmcnt(0)" ::: "memory");
            const unsigned og = xb_add(&bar[XB_TOP], 1u);
            const unsigned tg = og / nx;
            if (og + 1u == (tg + 1u) * nx) xb_add(&bar[XB_TOPGEN], 1u);
            else XB_SPIN(xb_ld(&bar[XB_TOPGEN]) == tg, bar);
            __builtin_amdgcn_fence(__ATOMIC_ACQUIRE, "agent");
            xb_add(&bar[XB_XGEN(b.x)], 1u);
            asm volatile("s_waitcnt vmcnt(0)" ::: "memory");
        } else {
            XB_SPIN(xb_ld(&bar[XB_XGEN(b.x)]) == gen, bar);
            __builtin_amdgcn_fence(__ATOMIC_ACQUIRE, "agent");
            asm volatile("s_waitcnt vmcnt(0)" ::: "memory");
        }
    }
    __syncthreads();
}

constexpr size_t MiB = 1u << 20;
constexpr size_t WS_CTL = 0;
constexpr size_t WS_SS = 1 * MiB;
constexpr size_t ZERO_BYTES = 4 * MiB;
constexpr size_t WS_ROUTE = 4 * MiB;
constexpr size_t WS_WR = 5 * MiB;
constexpr size_t WS_WIN = 6 * MiB;
constexpr size_t WS_WGLU = WS_WIN + 16 * MiB;
constexpr size_t WS_WOUT = WS_WGLU + 2 * MiB;
constexpr size_t WS_DGU = WS_WOUT + 8 * MiB;
constexpr size_t WS_DDN = WS_DGU + 22 * MiB;
constexpr size_t WS_MGU = WS_DDN + 11 * MiB;
constexpr size_t WS_MDN = WS_MGU + 224 * MiB;
constexpr size_t WS_SSMT = WS_MDN + 112 * MiB;
constexpr size_t WS_XB = WS_SSMT + 41 * MiB;
constexpr size_t WS_B = WS_XB + 64 * MiB;
static_assert(WS_B == 506 * MiB, "map");
constexpr size_t WS_UG = WS_B, WS_Q = WS_B + 32 * MiB, WS_K = WS_B + 64 * MiB, WS_V = WS_B + 96 * MiB, WS_Y = WS_B + 128 * MiB, WS_MIX = WS_B + 160 * MiB;
constexpr size_t WS_ATMP = WS_B + 224 * MiB;
constexpr size_t WS_VL = WS_B + 288 * MiB, WS_VR = WS_B + 320 * MiB;
constexpr size_t WS_SSMX = WS_ATMP;
constexpr size_t WS_HD = WS_B;
constexpr size_t WS_DDN1 = WS_DDN + (size_t)DM * DFF_P * 2;
constexpr size_t WS_XQ = WS_B + 192 * MiB;
constexpr size_t WS_XG = WS_B;
constexpr int MOE_TILES_MAX = (2 * M) / 256 + NEXP;
constexpr int MOE_ROWS = MOE_TILES_MAX * 256;
constexpr size_t WS_HM = WS_XG + 132 * MiB;
constexpr int HM_TILES = MOE_TILES_MAX;
constexpr size_t WS_END = WS_HM + (size_t)HM_TILES * 256 * DFE;
static_assert(WS_END <= 896 * MiB && WS_VR + 32 * MiB <= 896 * MiB && 2 * HM_TILES >= MOE_TILES_MAX, "d_ws budget");
constexpr int CW_BAR = 4096;
constexpr int CW_KMAX = 20480;
constexpr int CW_ATTQ = 24576;
constexpr int CW_ROUTE = 16384;
__host__ __device__ constexpr int SS_MIXN(int L) { return L; }
__host__ __device__ constexpr int SS_GLU(int L) { return 4 + L; }
__host__ __device__ constexpr int SS_FFN(int L) { return 8 + L; }

constexpr int RING_OFF = 0, RING_BYTES = 131072;
constexpr int LDSCTL_OFF = RING_BYTES, MISC_OFF = LDSCTL_OFF + 320;
constexpr int LDS_BYTES = 147456;
constexpr int NWAVES = 8;

struct Frame {
    LAS unsigned char* lds;
    volatile LAS unsigned* MISC;
    gu32* ctl;
    int tid, lane, wave;
    int vcu, G;
    float* out; unsigned char* ws;
};
struct Args { const float* in[30]; float* out; unsigned char* ws; int ph_lo, ph_hi; };
constexpr int ARGT_OFF = LDSCTL_OFF + 1024;
extern __shared__ __attribute__((aligned(16))) unsigned char g_lds[];
__device__ __forceinline__ unsigned long long argt(int k) {
    const LAS unsigned* t = (const LAS unsigned*)((LAS unsigned char*)g_lds + ARGT_OFF) + 2 * k;
    const unsigned lo = __builtin_amdgcn_readfirstlane(t[0]), hi = __builtin_amdgcn_readfirstlane(t[1]);
    return ((unsigned long long)hi << 32) | lo;
}
typedef float f32x2v __attribute__((ext_vector_type(2)));
struct ArgView { __device__ __forceinline__ const float* operator[](int k) const { return (const float*)argt(k); } };
__device__ __forceinline__ Frame make_frame() {
    Frame F;
    F.lds = (LAS unsigned char*)g_lds;
    F.MISC = (volatile LAS unsigned*)(F.lds + MISC_OFF);
    { int t_ = threadIdx.x; asm volatile("" : "+v"(t_)); F.tid = t_; } F.lane = F.tid & 63; F.wave = __builtin_amdgcn_readfirstlane(F.tid >> 6);
    F.G = gridDim.x; { const int bx = blockIdx.x; F.vcu = (F.G % 8 == 0) ? (bx % 8) * (F.G / 8) + bx / 8 : bx; }
    F.out = (float*)argt(30); F.ws = (unsigned char*)argt(31); F.ctl = (gu32*)(F.ws + WS_CTL);
    return F;
}
__device__ __forceinline__ float wave_sum(float v) {
#pragma unroll
    for (int o = 1; o < 64; o <<= 1) v += __shfl_xor(v, o);
    return v;
}
__device__ __forceinline__ float lambda_init(int L) { return 0.8f - 0.6f * expf(-0.3f * (float)L); }

template <int RMAP, int GK, bool QS>
__device__ __forceinline__ void cvt_item(const float* W, int K, int N, bf16* WT, int ldk, const float* g0, const float* g1, float g1s, LAS float* scr, int item, int lane) {
    const int nblk = N / 32, kb = item / nblk, nb = item % nblk, k0 = 64 * kb, n0 = 32 * nb;
    float cs = 1.f; if (QS) { if (n0 >= 512 && n0 < 1024) cs = QSCALE; }
    float wv[32];
#pragma unroll
    for (int i = 0; i < 32; ++i) { const int k = k0 + 2 * i + (lane >> 5); wv[i] = *(const GAS float*)(W + (size_t)k * N + n0 + (lane & 31)); }
#pragma unroll
    for (int i = 0; i < 32; ++i) { const int kk = 2 * i + (lane >> 5), k = k0 + kk;
        float gv = cs; if (GK == 1) gv *= g0[k]; if (GK == 2) gv *= (k < 512) ? g0[k] : g1[(k - 512) & 127] * g1s;
        scr[kk * 33 + (lane & 31)] = wv[i] * gv; }
    LDS_WAIT(); asm volatile("" ::: "memory");
    const int c = lane & 7;
#pragma unroll
    for (int j = 0; j < 4; ++j) { const int n = (lane >> 3) + 8 * j; const LAS float* s = scr + (8 * c) * 33 + n;
        v4u o; o.x = pk2(s[0 * 33], s[1 * 33]); o.y = pk2(s[2 * 33], s[3 * 33]); o.z = pk2(s[4 * 33], s[5 * 33]); o.w = pk2(s[6 * 33], s[7 * 33]);
        const int nn = n0 + n; const int drow = (RMAP == 0) ? nn : ((nn >> 7) * 256 + (nn & 127) + (RMAP == 2 ? 128 : 0));
        *(GAS v4u*)(WT + (size_t)drow * ldk + k0 + 8 * c) = o; }
    LDS_WAIT(); asm volatile("" ::: "memory");
}
constexpr float MOE_SX = 32.0f, MOE_SWGU = 1016.0f, MOE_SH = 16.0f, MOE_SWDN = 1900.0f;
#ifndef DEN_SH_V
#define DEN_SH_V 16.0f
#endif
#ifndef DEN_SWDN_V
#define DEN_SWDN_V 1666.0f
#endif
constexpr float DEN_SH = DEN_SH_V, DEN_SWDN = DEN_SWDN_V;
__device__ __forceinline__ unsigned pk4i8(float a, float b, float c, float d) {
    unsigned w = 0; w = __builtin_amdgcn_cvt_pk_u8_f32(__builtin_rintf(a) + 128.f, 0, w); w = __builtin_amdgcn_cvt_pk_u8_f32(__builtin_rintf(b) + 128.f, 1, w);
    w = __builtin_amdgcn_cvt_pk_u8_f32(__builtin_rintf(c) + 128.f, 2, w); w = __builtin_amdgcn_cvt_pk_u8_f32(__builtin_rintf(d) + 128.f, 3, w); return w ^ 0x80808080u; }
template <int RMAP, int GK>
__device__ __forceinline__ void cvt_item8(const float* W, int K, int N, unsigned char* WT, int ldk, const float* g0, float sw, LAS float* scr, int item, int lane) {
    const int nblk = N / 32, kb = item / nblk, nb = item % nblk, k0 = 64 * kb, n0 = 32 * nb;
    float wv[32];
#pragma unroll
    for (int i = 0; i < 32; ++i) { const int k = k0 + 2 * i + (lane >> 5); wv[i] = *(const GAS float*)(W + (size_t)k * N + n0 + (lane & 31)); }
#pragma unroll
    for (int i = 0; i < 32; ++i) { const int kk = 2 * i + (lane >> 5), k = k0 + kk; float gv = sw; if (GK == 1) gv *= g0[k];
        scr[kk * 33 + (lane & 31)] = wv[i] * gv; }
    LDS_WAIT(); asm volatile("" ::: "memory");
    const int c = lane & 3;
#pragma unroll
    for (int j = 0; j < 2; ++j) { const int n = (lane >> 2) + 16 * j; const LAS float* s = scr + (16 * c) * 33 + n;
        v4u o; o.x = pk4i8(s[0 * 33], s[1 * 33], s[2 * 33], s[3 * 33]); o.y = pk4i8(s[4 * 33], s[5 * 33], s[6 * 33], s[7 * 33]);
        o.z = pk4i8(s[8 * 33], s[9 * 33], s[10 * 33], s[11 * 33]); o.w = pk4i8(s[12 * 33], s[13 * 33], s[14 * 33], s[15 * 33]);
        const int nn = n0 + n; const int drow = (RMAP == 0) ? nn : ((nn >> 7) * 256 + (nn & 127) + (RMAP == 2 ? 128 : 0));
        *(GAS v4u*)(WT + (size_t)drow * ldk + k0 + 16 * c) = o; }
    LDS_WAIT(); asm volatile("" ::: "memory");
}
struct RowLoop { int start, end, step; };
__device__ __forceinline__ RowLoop row_loop(int gw, int NGW, int R) {
    const int rpw = M / NGW; const bool cont = rpw > 0 && rpw * NGW == M && rpw % R == 0;
    RowLoop l; l.start = cont ? gw * rpw : gw * R; l.end = cont ? l.start + rpw : M; l.step = cont ? R : NGW * R; return l;
}
__device__ __forceinline__ void ssm_tables(Frame& F, int ci);
__device__ __forceinline__ void p0_prologue(Frame& F) {
    LAS float* scr = (LAS float*)(F.lds + RING_OFF + F.wave * 16384);
    const int gw = F.vcu * NWAVES + F.wave, NGW = F.G * NWAVES;
    const ArgView in; unsigned char* ws = F.ws;
    { constexpr int IPM = (DM / 64) * (IN_COLS / 32);
      for (int it = gw; it < DEPTH * IPM; it += NGW) { const int L = it / IPM, r = it % IPM;
        cvt_item8<0, 1>(in[2] + (size_t)L * DM * IN_COLS, DM, IN_COLS, (unsigned char*)(ws + WS_WIN) + (size_t)L * IN_COLS * DM, DM, in[1] + L * DM, MOE_SWGU, scr, r, F.lane); } }
    { constexpr int IPM = (SSM_W / 64) * (SSM_W / 32);
      for (int it = gw; it < DEPTH * IPM; it += NGW) { const int L = it / IPM, r = it % IPM;
        cvt_item<0, 0, false>(in[11] + (size_t)L * SSM_W * SSM_W, SSM_W, SSM_W, (bf16*)(ws + WS_WGLU) + (size_t)L * SSM_W * SSM_W, SSM_W, nullptr, nullptr, 0.f, scr, r, F.lane); } }
    { constexpr int IPM = (DM / 64) * (DM / 32);
      for (int it = gw; it < DEPTH * IPM; it += NGW) { const int L = it / IPM, r = it % IPM;
        cvt_item<0, 2, false>(in[19] + (size_t)L * DM * DM, DM, DM, (bf16*)(ws + WS_WOUT) + (size_t)L * DM * DM, DM, in[13] + L * SSM_W, in[18] + L * ATT_DV, 1.0f - lambda_init(L), scr, r, F.lane); } }
    { constexpr int IPM = (DM / 64) * (DFF / 32);
      for (int it = gw; it < 2 * IPM; it += NGW) { const int j = it / IPM, r = it % IPM; unsigned char* dst = (unsigned char*)(ws + WS_DGU) + (size_t)j * (2 * DFF_P) * DM;
        cvt_item8<1, 1>(in[21] + (size_t)j * DM * DFF, DM, DFF, dst, DM, in[20] + (2 * j) * DM, MOE_SWGU, scr, r, F.lane);
        cvt_item8<2, 1>(in[22] + (size_t)j * DM * DFF, DM, DFF, dst, DM, in[20] + (2 * j) * DM, MOE_SWGU, scr, r, F.lane); }
      for (int it = gw; it < 2 * 128; it += NGW) { const int j = it >> 7, rr = it & 127; const int drow = 21 * 256 + ((rr < 64) ? 64 + rr : 192 + (rr - 64));
        GAS v4u* p = (GAS v4u*)((unsigned char*)(ws + WS_DGU) + ((size_t)j * (2 * DFF_P) + drow) * DM); p[F.lane] = (v4u){0u, 0u, 0u, 0u}; } }
    { constexpr int IPM = (DFF / 64) * (DM / 32);
      for (int it = gw; it < 2 * IPM; it += NGW) { const int j = it / IPM, r = it % IPM;
        cvt_item8<0, 0>(in[23] + (size_t)j * DFF * DM, DFF, DM, (unsigned char*)(ws + WS_DDN) + (size_t)j * DM * DFF_P, DFF_P, nullptr, DEN_SWDN, scr, r, F.lane); }
      for (int it = gw * 64 + F.lane; it < 2 * DM * 4; it += NGW * 64) { const int j = it / (DM * 4), r = (it / 4) % DM, c = it % 4;
        *(GAS v4u*)((unsigned char*)(ws + WS_DDN) + ((size_t)j * DM + r) * DFF_P + DFF + 16 * c) = (v4u){0u, 0u, 0u, 0u}; } }
    { constexpr int IPM = (DM / 64) * (DFE / 32);
      for (int it = gw; it < 2 * NEXP * IPM; it += NGW) { const int je = it / IPM, r = it % IPM, j = je / NEXP; unsigned char* dst = (unsigned char*)(ws + WS_MGU) + (size_t)je * (2 * DFE) * DM;
        cvt_item8<1, 1>(in[26] + (size_t)je * DM * DFE, DM, DFE, dst, DM, in[20] + (2 * j + 1) * DM, MOE_SWGU, scr, r, F.lane);
        cvt_item8<2, 1>(in[27] + (size_t)je * DM * DFE, DM, DFE, dst, DM, in[20] + (2 * j + 1) * DM, MOE_SWGU, scr, r, F.lane); } }
    { constexpr int IPM = (DFE / 64) * (DM / 32);
      for (int it = gw; it < 2 * NEXP * IPM; it += NGW) { const int je = it / IPM, r = it % IPM;
        cvt_item8<0, 0>(in[28] + (size_t)je * DFE * DM, DFE, DM, (unsigned char*)(ws + WS_MDN) + (size_t)je * DM * DFE, DFE, nullptr, MOE_SWDN, scr, r, F.lane); } }
    for (int it = gw * 64 + F.lane; it < 2 * NEXP * DM; it += NGW * 64) { const int j = it / (NEXP * DM), e = (it / DM) % NEXP, c = it % DM;
        ((float*)(ws + WS_WR))[it] = in[20][(2 * j + 1) * DM + c] * in[24][((size_t)j * DM + c) * NEXP + e]; }
    __syncthreads();
    for (int ci = blockIdx.x; ci < DEPTH * SSM_G * 2; ci += F.G) ssm_tables(F, ci);
    { unsigned long long* ss = (unsigned long long*)(ws + WS_SS) + (size_t)SS_MIXN(0) * M;
      const RowLoop rl = row_loop(gw, NGW, 2);
      for (int m0 = rl.start; m0 < rl.end; m0 += rl.step) {
        f32x4 v[2][4];
#pragma unroll
        for (int u = 0; u < 2; ++u) { const GAS f32x4* xr = (const GAS f32x4*)(in[0] + (size_t)(m0 + u) * DM) + F.lane;
#pragma unroll
          for (int j = 0; j < 4; ++j) v[u][j] = xr[64 * j]; }
#pragma unroll
        for (int u = 0; u < 2; ++u) { const int m = m0 + u;
          GAS unsigned long long* o8 = (GAS unsigned long long*)((bf16*)(ws + WS_XB) + (size_t)m * DM) + F.lane; float s = 0.f;
#pragma unroll
          for (int j = 0; j < 4; ++j) { const f32x4 w = v[u][j]; s += (w.x * w.x + w.y * w.y) + (w.z * w.z + w.w * w.w);
              o8[64 * j] = (unsigned long long)pk2(w.x, w.y) | ((unsigned long long)pk2(w.z, w.w) << 32); }
          s = wave_sum(s); if (F.lane == 0) ss[m] = (unsigned long long)(s * SS_FX);
          const float r = __builtin_amdgcn_rsqf(s * (1.0f / DM) + NORM_EPS) * MOE_SX; GAS unsigned* q4 = (GAS unsigned*)(ws + WS_XQ + (size_t)m * DM) + F.lane;
#pragma unroll
          for (int j = 0; j < 4; ++j) { const f32x4 w = v[u][j]; q4[64 * j] = pk4i8(w.x * r, w.y * r, w.z * r, w.w * r); } } } }
}

__device__ __forceinline__ float gelu_tanh(float y) {
    constexpr float k1 = -2.0f * 0.7978845608028654f * 1.4426950408889634f, k2 = k1 * 0.044715f;
    return y * __builtin_amdgcn_rcpf(1.0f + __builtin_amdgcn_exp2f(y * fmaf(k2, y * y, k1)));
}

constexpr int SSM_NFRAG = 144, SSM_TAB_BF = SSM_NFRAG * 1024, SSM_AK_OFF = SSM_TAB_BF, SSM_PT_OFF = SSM_AK_OFF + 6 * 64 * 8, SSM_TAB_BYTES = SSM_PT_OFF + 32 * 64 * 8;
static_assert(SSM_TAB_BYTES == 166912 && (size_t)DEPTH * SSM_G * 2 * SSM_TAB_BYTES <= 41 * MiB, "ssm tables");

__device__ __forceinline__ void cexp_pow(float lre, double lim, float step, int e, float& re, float& im) {
    const float mag = __builtin_amdgcn_exp2f((float)e * lre * step * 1.4426950408889634f);
    double rev = (double)e * lim * (double)step * 0.15915494309189533577; rev -= rint(rev);
    const float rf = (float)rev; re = mag * __builtin_amdgcn_cosf(rf); im = mag * __builtin_amdgcn_sinf(rf);
}
__device__ __forceinline__ void ssm_tables(Frame& F, int ci) {
    const ArgView in; const int d = ci & 1, pidx = ((ci >> 6) * 2 + d) * SSM_G + ((ci >> 1) & 31);
    LAS float* pwr = (LAS float*)(F.lds + RING_OFF);
    LAS float* pwi = pwr + 64 * 17;
    LAS float* bbr = pwi + 64 * 17;
    LAS float* bbi = bbr + 64 * 16;
    LAS float* cr = bbi + 64 * 16;
    LAS float* cim = cr + 16 * 64;
    LAS float* Kt = cim + 16 * 64;
    unsigned char* tab = F.ws + WS_SSMT + (size_t)ci * SSM_TAB_BYTES;
    const float step = expf(in[5][pidx]);
    { float* ak = (float*)(tab + SSM_AK_OFF); float* pt = (float*)(tab + SSM_PT_OFF);
      for (int it = F.tid; it < 64 * 55; it += NWAVES * 64) { const int p = it & 63, j = it >> 6;
        const float lre = in[3][pidx * 64 + p]; const double lim = (double)in[4][pidx * 64 + p];
        const int e = j < 17 ? j : (j < 23 ? (16 << (j - 17)) : 16 * (j - 23)); float re, im; cexp_pow(lre, lim, step, e, re, im);
        const int mb = p >> 4, pl = p & 15, hi = (pl >> 1) & 1, qq = (pl & 1) | ((pl >> 2) << 1), slot = (hi * 4 + mb) * 8 + qq;
        if (j < 17) { pwr[p * 17 + j] = re; pwi[p * 17 + j] = im; }
        else if (j < 23) { ak[((j - 17) * 64 + slot) * 2] = re; ak[((j - 17) * 64 + slot) * 2 + 1] = im; }
        else { pt[((j - 23) * 64 + slot) * 2] = re; pt[((j - 23) * 64 + slot) * 2 + 1] = im; } } }
    __syncthreads();
    for (int it = F.tid; it < 64 * 16; it += NWAVES * 64) { const int p = it >> 4, h = it & 15; const float lre = in[3][pidx * 64 + p], limf = in[4][pidx * 64 + p];
        const float ar = pwr[p * 17 + 1], ai = pwi[p * 17 + 1], den = lre * lre + limf * limf;
        const float cfr = ((ar - 1.f) * lre + ai * limf) / den, cfi = (ai * lre - (ar - 1.f) * limf) / den;
        const float br = in[6][((size_t)pidx * 64 + p) * 16 + h], bi = in[7][((size_t)pidx * 64 + p) * 16 + h]; bbr[p * 16 + h] = cfr * br - cfi * bi; bbi[p * 16 + h] = cfr * bi + cfi * br; }
    for (int i = F.tid; i < 1024; i += NWAVES * 64) { cr[i] = in[8][(size_t)pidx * 1024 + i]; cim[i] = in[9][(size_t)pidx * 1024 + i]; }
    __syncthreads();
    { const int h = (F.tid >> 4) & 15, hp = F.tid & 15, t0 = (F.tid >> 8) * 8; float a8[8];
#pragma unroll
      for (int t = 0; t < 8; ++t) a8[t] = 0.f;
      for (int p = 0; p < 64; ++p) { const float c_r = cr[h * 64 + p], c_i = cim[h * 64 + p], b_r = bbr[p * 16 + hp], b_i = bbi[p * 16 + hp];
          const float xr = c_r * b_r - c_i * b_i, xi = c_r * b_i + c_i * b_r;
#pragma unroll
          for (int t = 0; t < 8; ++t) a8[t] += xr * pwr[p * 17 + t0 + t] - xi * pwi[p * 17 + t0 + t]; }
#pragma unroll
      for (int t = 0; t < 8; ++t) Kt[((t0 + t) * 16 + h) * 16 + hp] = a8[t]; }
    __syncthreads();
    for (int it = F.tid; it < SSM_NFRAG * 64; it += NWAVES * 64) { const int f = it >> 6, l = it & 63, i = l & 31, hiA = l >> 5; float v[8];
        const int slr = i >> 4, h = i & 15, sl_eff = d ? 1 - slr : slr;
        if (f < 16) {
#pragma unroll
            for (int q = 0; q < 8; ++q) { const int t = f - 1 + sl_eff; v[q] = (t >= 0 && t < 16) ? Kt[(t * 16 + h) * 16 + 8 * hiA + q] : 0.f; }
        } else if (f < 80) { const int mb = (f - 16) >> 4, sp_ = (f - 16) & 15, p = 16 * mb + (i >> 1), ri = i & 1, e = 15 - sp_; const float wr_ = pwr[p * 17 + e], wi_ = pwi[p * 17 + e];
#pragma unroll
            for (int q = 0; q < 8; ++q) { const float b_r = bbr[p * 16 + 8 * hiA + q], b_i = bbi[p * 16 + 8 * hiA + q]; v[q] = ri == 0 ? wr_ * b_r - wi_ * b_i : wr_ * b_i + wi_ * b_r; }
        } else { const int sp = (f - 80) >> 3, ks = (f - 80) & 7, mb = ks >> 1, half = ks & 1, s = 2 * sp + sl_eff;
#pragma unroll
            for (int q = 0; q < 8; ++q) { const int iblk = 16 * half + (q & 3) + 8 * (q >> 2) + 4 * hiA, p = 16 * mb + (iblk >> 1), ri = iblk & 1;
                const float c_r = cr[h * 64 + p], c_i = cim[h * 64 + p], wr_ = pwr[p * 17 + s + 1], wi_ = pwi[p * 17 + s + 1];
                v[q] = ri == 0 ? c_r * wr_ - c_i * wi_ : -(c_r * wi_ + c_i * wr_); }
        }
        v4u o; o.x = pk2(v[0], v[1]); o.y = pk2(v[2], v[3]); o.z = pk2(v[4], v[5]); o.w = pk2(v[6], v[7]);
        *(GAS v4u*)(tab + (size_t)f * 1024 + l * 16) = o; }
    __syncthreads();
}

namespace ssm {
using bf16x8 = __attribute__((ext_vector_type(8))) short;
using f32x16 = __attribute__((ext_vector_type(16))) float;
typedef __attribute__((address_space(3))) const bf16x8 lbf16x8;
__device__ __forceinline__ bf16x8 lfrag(const LAS unsigned char* base, int f, int lane) { return *(lbf16x8*)(base + f * 1024 + lane * 16); }
__device__ __forceinline__ void lds_copy(LAS unsigned char* dst, const unsigned char* src, int nbytes, int tid) {
    const int wv = __builtin_amdgcn_readfirstlane(tid >> 6), ln = tid & 63;
    for (int o = wv * 1024; o < nbytes; o += NWAVES * 1024)
        __builtin_amdgcn_global_load_lds((const unsigned*)(src + o + ln * 16), (LAS unsigned*)(dst + o), 16, 0, 0);
}
template <int D>
__device__ __forceinline__ void ssm_scan(const LAS unsigned char* wsl, const unsigned char* tab, const bf16* ug  , LAS float* totl, const LAS float* akl  , const LAS float* zt  , unsigned char* xg  , int wave, int lane_) {
    int lane = lane_; asm volatile("" : "+v"(lane));
    const int n = lane & 31, hi = lane >> 5, nrel = D ? 31 - n : n;
    const bf16* ul = ug + ((size_t)(512 * wave + 16 * n) * 16 + 8 * hi);
    const LAS float* ak = akl + hi * 64;
    const float* pt = (const float*)(tab + SSM_PT_OFF) + (nrel * 64 + hi * 32) * 2;
    f32x16 S[4];
#pragma unroll
    for (int mb = 0; mb < 4; ++mb) S[mb] = f32x16{};
#pragma unroll
    for (int h8 = 0; h8 < 16; h8 += 8) {
        bf16x8 uf[8];
#pragma unroll
        for (int e = 0; e < 8; ++e) uf[e] = *(const GAS bf16x8*)(ul + (D ? 15 - (h8 + e) : h8 + e) * 16);
#pragma unroll
        for (int e = 0; e < 8; ++e) {
#pragma unroll
            for (int mb = 0; mb < 4; ++mb) S[mb] = __builtin_amdgcn_mfma_f32_32x32x16_bf16(lfrag(wsl, mb * 16 + h8 + e, lane), uf[e], S[mb], 0, 0, 0);
            if ((e & 1) == 1) asm volatile("" ::: "memory"); } }
    asm volatile("" ::: "memory");
#pragma unroll
    for (int mb = 0; mb < 4; ++mb) {
#pragma unroll
        for (int k = 0; k < 5; ++k) { const int dd = 1 << k; const LAS float* akk = nrel >= dd ? ak + k * 128 : zt;
#pragma unroll
            for (int qq = 0; qq < 8; ++qq) { const f32x2v av = *(const LAS f32x2v*)(akk + (mb * 8 + qq) * 2); const float a_r = av.x, a_i = av.y;
                const float vr = D ? __shfl_down(S[mb][2 * qq], dd, 32) : __shfl_up(S[mb][2 * qq], dd, 32), vi = D ? __shfl_down(S[mb][2 * qq + 1], dd, 32) : __shfl_up(S[mb][2 * qq + 1], dd, 32);
                S[mb][2 * qq] += a_r * vr - a_i * vi; S[mb][2 * qq + 1] += a_r * vi + a_i * vr; }
            asm volatile("" ::: "memory"); }
        if (nrel == 31) {
#pragma unroll
            for (int r = 0; r < 16; ++r) totl[(wave * 2 + hi) * 64 + mb * 16 + r] = S[mb][r]; }
    }
    LDS_WAIT(); __syncthreads();
    f32x2v ptv[4][8];
#pragma unroll
    for (int mb = 0; mb < 4; ++mb)
#pragma unroll
        for (int qq = 0; qq < 8; ++qq) ptv[mb][qq] = *(const GAS f32x2v*)(pt + (mb * 8 + qq) * 2);
#pragma unroll
    for (int mb = 0; mb < 4; ++mb) {
        float cy[16];
#pragma unroll
        for (int r = 0; r < 16; ++r) cy[r] = 0.f;
        const int nprev = D ? 7 - wave : wave;
        for (int j = 0; j < nprev; ++j) { const int w2 = D ? 7 - j : j; const LAS float* tp = totl + (w2 * 2 + hi) * 64 + mb * 16;
#pragma unroll
            for (int qq = 0; qq < 8; ++qq) { const f32x2v av = *(const LAS f32x2v*)(ak + 5 * 128 + (mb * 8 + qq) * 2);
                const float cr_ = cy[2 * qq], ci_ = cy[2 * qq + 1];
                cy[2 * qq] = av.x * cr_ - av.y * ci_ + tp[2 * qq]; cy[2 * qq + 1] = av.x * ci_ + av.y * cr_ + tp[2 * qq + 1]; } }
        float x[16];
#pragma unroll
        for (int qq = 0; qq < 8; ++qq) { const f32x2v pv = ptv[mb][qq];
            float er = D ? __shfl_down(S[mb][2 * qq], 1, 32) : __shfl_up(S[mb][2 * qq], 1, 32), ei = D ? __shfl_down(S[mb][2 * qq + 1], 1, 32) : __shfl_up(S[mb][2 * qq + 1], 1, 32);
            if (nrel == 0) { er = 0.f; ei = 0.f; }
            x[2 * qq] = er + pv.x * cy[2 * qq] - pv.y * cy[2 * qq + 1]; x[2 * qq + 1] = ei + pv.x * cy[2 * qq + 1] + pv.y * cy[2 * qq]; }
        v4u w0, w1; w0.x = pk2(x[0], x[1]); w0.y = pk2(x[2], x[3]); w0.z = pk2(x[4], x[5]); w0.w = pk2(x[6], x[7]); w1.x = pk2(x[8], x[9]); w1.y = pk2(x[10], x[11]); w1.z = pk2(x[12], x[13]); w1.w = pk2(x[14], x[15]);
        *(GAS v4u*)(xg + (2 * mb) * 1024 + lane * 16) = w0; *(GAS v4u*)(xg + (2 * mb + 1) * 1024 + lane * 16) = w1;
        asm volatile("" ::: "memory");
    }
    VM_WAIT(); LDS_WAIT(); __syncthreads();
}
template <int D, int HALF>
__device__ __forceinline__ void ssm_out(f32x16 (&acc)[4], const LAS unsigned char* ktl, const LAS unsigned char* wcl, const bf16x8 (&uf)[16], const unsigned char* xg, int wave, int lane_) {
    int lane = lane_; asm volatile("" : "+v"(lane));
    constexpr int SP_LO = D ? 4 * (1 - HALF) : 4 * HALF;
    bf16x8 xf[8];
#pragma unroll
    for (int ks = 0; ks < 8; ++ks) xf[ks] = *(const GAS bf16x8*)(xg + ks * 1024 + lane * 16);
#pragma unroll
    for (int q = 0; q < 4; ++q) { const int spa = 4 * HALF + q, sp = D ? 7 - spa : spa; f32x16 a = acc[q];
#pragma unroll
        for (int ks = 0; ks < 8; ++ks) a = __builtin_amdgcn_mfma_f32_32x32x16_bf16(lfrag(wcl, (sp - SP_LO) * 8 + ks, lane), xf[ks], a, 0, 0, 0);
#pragma unroll
        for (int sp_ = 0; sp_ < 16; ++sp_) if (sp_ <= 2 * sp + 1) {
            a = __builtin_amdgcn_mfma_f32_32x32x16_bf16(lfrag(ktl, 2 * sp - sp_ + 1, lane), uf[D ? 15 - sp_ : sp_], a, 0, 0, 0);
            if ((sp_ & 3) == 3) asm volatile("" ::: "memory"); }
        acc[q] = a; asm volatile("" ::: "memory"); }
}
template <int HALF>
__device__ __forceinline__ void ssm_epi(const f32x16 (&acc)[4], const bf16x8 (&uf)[16], bf16* Yg  , f32x4 d0, f32x4 d1, int wave, int lane_) {
    int lane = lane_; asm volatile("" : "+v"(lane));
    const int n = lane & 31, hi = lane >> 5;
    bf16* ylb = Yg + (size_t)(512 * wave + 16 * n) * SSM_W + 4 * hi;
    asm volatile("" : "+v"(ylb));
#pragma unroll
    for (int q = 0; q < 4; ++q)
#pragma unroll
        for (int sl = 0; sl < 2; ++sl) { const int t = 2 * (4 * HALF + q) + sl;
            const v4u w = __builtin_bit_cast(v4u, uf[t]);
            const unsigned s0 = hi ? w.x : w.z, s1 = hi ? w.y : w.w;
            const unsigned r0 = (unsigned)__shfl_xor((int)s0, 32), r1 = (unsigned)__shfl_xor((int)s1, 32);
            const unsigned a0 = hi ? r0 : w.x, a1 = hi ? r1 : w.y, b0 = hi ? w.z : r0, b1 = hi ? w.w : r1;
            const float y0 = gelu_tanh(acc[q][8 * sl + 0] + d0.x * __uint_as_float(a0 << 16)), y1 = gelu_tanh(acc[q][8 * sl + 1] + d0.y * __uint_as_float(a0 & 0xffff0000u));
            const float y2 = gelu_tanh(acc[q][8 * sl + 2] + d0.z * __uint_as_float(a1 << 16)), y3 = gelu_tanh(acc[q][8 * sl + 3] + d0.w * __uint_as_float(a1 & 0xffff0000u));
            const float y4 = gelu_tanh(acc[q][8 * sl + 4] + d1.x * __uint_as_float(b0 << 16)), y5 = gelu_tanh(acc[q][8 * sl + 5] + d1.y * __uint_as_float(b0 & 0xffff0000u));
            const float y6 = gelu_tanh(acc[q][8 * sl + 6] + d1.z * __uint_as_float(b1 << 16)), y7 = gelu_tanh(acc[q][8 * sl + 7] + d1.w * __uint_as_float(b1 & 0xffff0000u));
            *(GAS unsigned long long*)(ylb + t * SSM_W) = (unsigned long long)pk2(y0, y1) | ((unsigned long long)pk2(y2, y3) << 32);
            *(GAS unsigned long long*)(ylb + t * SSM_W + 8) = (unsigned long long)pk2(y4, y5) | ((unsigned long long)pk2(y6, y7) << 32); }
}
}
__device__ __forceinline__ void ssm_unit(Frame& F, int L, int unit) {
    const int b = unit >> 5, g = unit & 31; const ArgView in;
    const bf16* ug = (const bf16*)(F.ws + WS_UG) + ((size_t)g * M + (size_t)b * SEQ) * 16;
    LAS float* totl = (LAS float*)(F.lds + LDSCTL_OFF + 4096);
    LAS unsigned char* ring = F.lds + RING_OFF;
    const unsigned char* tab0 = F.ws + WS_SSMT + (size_t)((L * SSM_G + g) * 2) * SSM_TAB_BYTES; const unsigned char* tab1 = tab0 + SSM_TAB_BYTES;
    unsigned char* xg0 = F.ws + WS_SSMX + ((size_t)blockIdx.x * 16 + F.wave) * 8192; unsigned char* xg1 = xg0 + 8 * 8192;
    LAS float* akl = (LAS float*)(F.lds + LDSCTL_OFF + 8192);
    __syncthreads();
    { float akv[3];
#pragma unroll
      for (int q = 0; q < 3; ++q) { const int i = F.tid + q * NWAVES * 64; akv[q] = ((const GAS float*)((i < 768 ? tab0 : tab1) + SSM_AK_OFF))[i < 768 ? i : i - 768]; }
#pragma unroll
      for (int q = 0; q < 3; ++q) akl[F.tid + q * NWAVES * 64] = akv[q]; }
    ssm::lds_copy(ring, tab0 + 16 * 1024, 65536, F.tid); ssm::lds_copy(ring + 65536, tab1 + 16 * 1024, 65536, F.tid);
    VM_WAIT(); LDS_WAIT(); __syncthreads();
    const LAS float* zt = (const LAS float*)(F.lds + LDSCTL_OFF + 14336);
    const int sl = F.wave < 4 ? F.wave : 11 - F.wave;
    ssm::ssm_scan<0>(ring, tab0, ug, totl, akl, zt, xg0, sl, F.lane);
    ssm::ssm_scan<1>(ring + 65536, tab1, ug, totl, akl + 768, zt, xg1, sl, F.lane);
    ssm::bf16x8 uf[16];
    { const bf16* ul = ug + ((size_t)(512 * sl + 16 * (F.lane & 31)) * 16 + 8 * (F.lane >> 5));
#pragma unroll
      for (int s_ = 0; s_ < 16; ++s_) uf[s_] = *(const GAS ssm::bf16x8*)(ul + s_ * 16); }
    bf16* Yg = (bf16*)(F.ws + WS_Y) + (size_t)b * SEQ * SSM_W + g * 16; const float* dsk = in[10] + L * SSM_W + g * 16;
    const int hi = F.lane >> 5;
    const f32x4 d0 = *(const f32x4*)(dsk + 4 * hi), d1 = *(const f32x4*)(dsk + 8 + 4 * hi);
    {
        ssm::lds_copy(ring, tab0, 16384, F.tid); ssm::lds_copy(ring + 16384, tab1, 16384, F.tid);
        ssm::lds_copy(ring + 32768, tab0 + 80 * 1024, 32768, F.tid); ssm::lds_copy(ring + 65536, tab1 + 112 * 1024, 32768, F.tid);
        VM_WAIT(); LDS_WAIT(); __syncthreads();
        ssm::f32x16 acc[4];
#pragma unroll
        for (int i = 0; i < 4; ++i) acc[i] = ssm::f32x16{};
        ssm::ssm_out<0, 0>(acc, ring, ring + 32768, uf, xg0, sl, F.lane); ssm::ssm_out<1, 0>(acc, ring + 16384, ring + 65536, uf, xg1, sl, F.lane);
        ssm::ssm_epi<0>(acc, uf, Yg, d0, d1, sl, F.lane); }
    LDS_WAIT(); __syncthreads();
    {
        ssm::lds_copy(ring + 32768, tab0 + 112 * 1024, 32768, F.tid); ssm::lds_copy(ring + 65536, tab1 + 80 * 1024, 32768, F.tid);
        VM_WAIT(); LDS_WAIT(); __syncthreads();
        ssm::f32x16 acc[4];
#pragma unroll
        for (int i = 0; i < 4; ++i) acc[i] = ssm::f32x16{};
        ssm::ssm_out<0, 1>(acc, ring, ring + 32768, uf, xg0, sl, F.lane); ssm::ssm_out<1, 1>(acc, ring + 16384, ring + 65536, uf, xg1, sl, F.lane);
        ssm::ssm_epi<1>(acc, uf, Yg, d0, d1, sl, F.lane); }
    LDS_WAIT(); __syncthreads();
}

__device__ __forceinline__ void attn_unit(Frame& F, int L, int unit, float lam) {
    using namespace att;
    const int qb = unit & 15, h = (unit >> 4) & 3, b = unit >> 6;
    const int tid = F.tid, wid = tid >> 6, lane = tid & 63, r32 = lane & 31, hi = lane >> 5;
    const att::bf16* Qb = (const att::bf16*)(F.ws + WS_Q); const att::bf16* Kb = (const att::bf16*)(F.ws + WS_K); const att::bf16* Vb = (const att::bf16*)(F.ws + WS_V);
    const float slope2 = exp2f(-2.0f * (float)(h + 1)) * 1.4426950408889634f;
    const size_t rowb = (size_t)b * SEQ; const int q0 = qb * 256;
    att::lchar* lds = (att::lchar*)(F.lds + RING_OFF);
    att::lfloat* ws = (att::lfloat*)(lds + 2 * SHM_V + 2 * SHM_K) + wid * 64;
    att::lfloat* wsall = (att::lfloat*)(lds + 2 * SHM_V + 2 * SHM_K);
    const gu32* kmx = F.ctl + CW_KMAX + L * 128 + (b * 4 + h) * 4;
    float k2[2];
#pragma unroll
    for (int mp = 0; mp < 2; ++mp) k2[mp] = __uint_as_float(__hip_atomic_load(kmx + mp * 2, RLX_AGENT)) + __uint_as_float(__hip_atomic_load(kmx + mp * 2 + 1, RLX_AGENT));
#pragma unroll 1
    for (int mp = 0; mp < 2; ++mp) {
        f32x16 o[4]; float l;
        attn_pass(Qb + (rowb + q0 + wid * 32) * LDQ + h * 128 + mp * 64, Kb + rowb * LDQ + h * 128 + mp * 64, Vb + rowb * LDQ + h * 128, (long)((WS_VL - WS_V) / 2), (long)((WS_VR - WS_V) / 2),
                  qb, slope2, mp ? k2[1] : k2[0], lds, o, l);
        int tq_ = threadIdx.x; asm volatile("" : "+v"(tq_));
        const int etid = tq_, ewid = __builtin_amdgcn_readfirstlane(etid >> 6), elane = etid & 63, er32 = elane & 31, ehi = elane >> 5;
        att::lfloat* ews = wsall + ewid * 64;
        if (ehi == 0) ews[er32] = l; asm volatile("s_waitcnt lgkmcnt(0)" ::: "memory");
        int un = unit; asm volatile("" : "+s"(un));
        const size_t rowe = (size_t)(un >> 6) * SEQ + (size_t)(un & 15) * 256 + ewid * 32; const int he = (un >> 4) & 3;
        GAS f32x4* A4 = (GAS f32x4*)(F.ws + WS_ATMP) + ((size_t)(((un >> 6) * 4 + he) * 16 + (un & 15)) * 16) * 512 + etid;
        if (mp == 0) {
#pragma unroll
            for (int j = 0; j < 4; ++j) { const float r0 = __builtin_amdgcn_rcpf(ews[crow(4 * j, ehi)]), r1 = __builtin_amdgcn_rcpf(ews[crow(4 * j + 1, ehi)]), r2 = __builtin_amdgcn_rcpf(ews[crow(4 * j + 2, ehi)]), r3 = __builtin_amdgcn_rcpf(ews[crow(4 * j + 3, ehi)]);
#pragma unroll
                for (int d0 = 0; d0 < 4; ++d0) A4[(d0 * 4 + j) * 512] = (f32x4){o[d0][4 * j] * r0, o[d0][4 * j + 1] * r1, o[d0][4 * j + 2] * r2, o[d0][4 * j + 3] * r3};
                asm volatile("" ::: "memory"); }
        } else {
            f32x4 a0v[4][4]; unsigned long long ssv[16];
            { const unsigned long long* ssp = (const unsigned long long*)(F.ws + WS_SS) + (size_t)SS_GLU(L) * M + rowe + 4 * ehi; asm volatile("" : "+v"(ssp));
#pragma unroll
              for (int d0 = 0; d0 < 4; ++d0)
#pragma unroll
                  for (int j = 0; j < 4; ++j) a0v[d0][j] = A4[(d0 * 4 + j) * 512];
#pragma unroll
              for (int r = 0; r < 16; ++r) ssv[r] = *(const GAS unsigned long long*)(ssp + crow(r, 0)); }
            att::lchar* tl = lds + 65536 + ewid * 8192;
#pragma unroll
            for (int r = 0; r < 16; ++r) { const int orow = crow(r, ehi); const float rlm = __builtin_amdgcn_rcpf(ews[orow]) * lam; float v[4]; float sq = 0.f;
#pragma unroll
                for (int d0 = 0; d0 < 4; ++d0) { v[d0] = a0v[d0][r >> 2][r & 3] - o[d0][r] * rlm; sq += v[d0] * v[d0]; }
                sq += __shfl_xor(sq, 1); sq += __shfl_xor(sq, 2); sq += __shfl_xor(sq, 4); sq += __shfl_xor(sq, 8); sq += __shfl_xor(sq, 16);
                const float invrg = sqrtf((float)ssv[r] * SS_FX_INV * (1.0f / SSM_W) + NORM_EPS);
                const float sc = invrg * __builtin_amdgcn_rsqf(sq * (1.0f / ATT_DV) + NORM_EPS);
#pragma unroll
                for (int d0 = 0; d0 < 4; ++d0) *(__attribute__((address_space(3))) unsigned short*)(tl + orow * 256 + (d0 * 32 + er32) * 2) = (unsigned short)f2bf(v[d0] * sc); }
            asm volatile("s_waitcnt lgkmcnt(0)" ::: "memory");
            { att::bf16* Ow = (att::bf16*)(F.ws + WS_MIX) + rowe * DM + 512 + he * 128;
#pragma unroll
              for (int k = 0; k < 8; ++k) { const v4u w = *(const __attribute__((address_space(3))) v4u*)(tl + (k * 64 + elane) * 16);
                  *(GAS v4u*)(Ow + (size_t)(4 * k + (elane >> 4)) * DM + (elane & 15) * 8) = w; } }
        }
        asm volatile("s_waitcnt vmcnt(0) lgkmcnt(0)" ::: "memory");
        __syncthreads();
    }
}
__device__ __forceinline__ void attn_phase(Frame& F, int L, int rep = 0) {
    const ArgView in;
    const float d1 = wave_sum(in[14][L * 64 + F.lane] * in[15][L * 64 + F.lane]), d2 = wave_sum(in[16][L * 64 + F.lane] * in[17][L * 64 + F.lane]);
    const float lam = expf(d1) - expf(d2) + lambda_init(L);
    LAS int* qslot = (LAS int*)(F.lds + LDSCTL_OFF + 2048);
    gu32* qctr = F.ctl + CW_ATTQ + rep * 256 + L * 64;
    const int x0 = (int)(xb_xcc_id() & 7u);
    int qi = 0;
    for (;;) {
        if (F.tid == 0) { int got = -1;
            while (qi < 8) { const int q = (x0 + qi) & 7; const unsigned idx = __hip_atomic_fetch_add(qctr + q * 8, 1u, RLX_AGENT);
                if (idx < (unsigned)(ATT_H * (SEQ / 256))) { got = (q << 6) | (int)idx; break; } ++qi; }
            qslot[0] = got; qslot[1] = qi; }
        LDS_WAIT(); __syncthreads();
        const int got = __builtin_amdgcn_readfirstlane(qslot[0]); qi = __builtin_amdgcn_readfirstlane(qslot[1]);
        __syncthreads();
        if (got < 0) break;
        const int b = got >> 6, idx = got & 63, h = 3 - (idx >> 4), qb = idx & 15;
        attn_unit(F, L, (b << 6) | (h << 4) | qb, lam);
    }
}

constexpr size_t WS_SSG = WS_WR + 128 * 1024;
static_assert(WS_SSG + (size_t)MOE_ROWS * 8 <= WS_WIN, "ssg fits behind the router weights");
__device__ __forceinline__ float grp16_sum(float v) { v += __shfl_xor(v, 1); v += __shfl_xor(v, 2); v += __shfl_xor(v, 4); v += __shfl_xor(v, 8); return v; }
__device__ __forceinline__ void moe_route(Frame& F, int j) {
    const float* wr = (const float*)(F.ws + WS_WR) + (size_t)j * NEXP * DM; const float* br = (const float*)argt(25) + j * NEXP;
    int* r_e = (int*)(F.ws + WS_ROUTE); int* r_pos = r_e + 2 * M; float* r_w = (float*)(r_pos + 2 * M);
    gu32* cnt = F.ctl + CW_ROUTE + j * 64;
    LAS float* wl = (LAS float*)(F.lds + RING_OFF);
    LAS unsigned* lcnt = (LAS unsigned*)(F.lds + RING_OFF + 32768);
    ssm::lds_copy((LAS unsigned char*)wl, (const unsigned char*)wr, NEXP * DM * 4, F.tid);
    if (F.tid < 16) lcnt[F.tid] = 0u;
    VM_WAIT(); LDS_WAIT(); __syncthreads();
    const int g = F.lane >> 4, t = F.lane & 15;
    const int gw = F.vcu * NWAVES + F.wave, NGW = F.G * NWAVES, NBLK = M / 16, nit = (NBLK + NGW - 1) / NGW;
    float bias[NEXP];
#pragma unroll
    for (int e = 0; e < NEXP; ++e) bias[e] = br[e];
    for (int it = 0; it < nit; ++it) {
        const int blk = it * NGW + gw; const bool valid = blk < NBLK;
        int e0s[4], e1s[4], l0s[4], l1s[4]; float w0s[4];
#pragma unroll
        for (int bb = 0; bb < 4; ++bb) {
            const int m = blk * 16 + bb * 4 + g; e0s[bb] = 0; e1s[bb] = 1; l0s[bb] = 0; l1s[bb] = 0; w0s[bb] = 0.f;
            if (valid) {
                const GAS unsigned long long* xr = (const GAS unsigned long long*)((const bf16*)(F.ws + WS_XB) + (size_t)m * DM) + t; unsigned long long xw[16]; f32x4 x[16]; float ss = 0.f, dot[NEXP];
#pragma unroll
                for (int i = 0; i < 16; ++i) xw[i] = xr[16 * i];
#pragma unroll
                for (int i = 0; i < 16; ++i) { const unsigned a0 = (unsigned)xw[i], a1 = (unsigned)(xw[i] >> 32); x[i] = (f32x4){__uint_as_float(a0 << 16), __uint_as_float(a0 & 0xffff0000u), __uint_as_float(a1 << 16), __uint_as_float(a1 & 0xffff0000u)}; }
#pragma unroll
                for (int e = 0; e < NEXP; ++e) dot[e] = 0.f;
#pragma unroll
                for (int i = 0; i < 16; ++i) { ss += (x[i].x * x[i].x + x[i].y * x[i].y) + (x[i].z * x[i].z + x[i].w * x[i].w);
#pragma unroll
                    for (int e = 0; e < NEXP; ++e) { const f32x4 w = *(const LAS f32x4*)(wl + e * DM + 64 * i + 4 * t); dot[e] += (x[i].x * w.x + x[i].y * w.y) + (x[i].z * w.z + x[i].w * w.w); } }
                ss = grp16_sum(ss); const float r = 1.0f / sqrtf(ss * (1.0f / DM) + NORM_EPS);
                float lg[NEXP];
#pragma unroll
                for (int e = 0; e < NEXP; ++e) lg[e] = grp16_sum(dot[e]) * r + bias[e];
                int i0 = 0; float v0 = lg[0];
#pragma unroll
                for (int e = 1; e < NEXP; ++e) if (lg[e] > v0) { v0 = lg[e]; i0 = e; }
                int i1 = -1; float v1 = -3.0e38f;
#pragma unroll
                for (int e = 0; e < NEXP; ++e) if (e != i0 && lg[e] > v1) { v1 = lg[e]; i1 = e; }
                e0s[bb] = i0; e1s[bb] = i1; w0s[bb] = 1.0f / (1.0f + expf(v1 - v0));
                if (t == 0) { l0s[bb] = (int)__hip_atomic_fetch_add(lcnt + i0, 1u, __ATOMIC_RELAXED, __HIP_MEMORY_SCOPE_WORKGROUP); l1s[bb] = (int)__hip_atomic_fetch_add(lcnt + i1, 1u, __ATOMIC_RELAXED, __HIP_MEMORY_SCOPE_WORKGROUP); }
            }
        }
        LDS_WAIT(); __syncthreads();
        if (F.tid < NEXP) { const unsigned n = lcnt[F.tid]; lcnt[8 + F.tid] = n ? __hip_atomic_fetch_add(cnt + F.tid, n, RLX_AGENT) : 0u; }
        LDS_WAIT(); __syncthreads();
        if (valid && t == 0) {
#pragma unroll
            for (int bb = 0; bb < 4; ++bb) { const int m = blk * 16 + bb * 4 + g;
                r_e[2 * m] = e0s[bb]; r_e[2 * m + 1] = e1s[bb]; r_pos[2 * m] = (int)lcnt[8 + e0s[bb]] + l0s[bb]; r_pos[2 * m + 1] = (int)lcnt[8 + e1s[bb]] + l1s[bb];
                r_w[2 * m] = w0s[bb]; r_w[2 * m + 1] = 1.0f - w0s[bb]; } }
        __syncthreads();
        if (F.tid < 8) lcnt[F.tid] = 0u;
        LDS_WAIT(); __syncthreads();
    }
}
__device__ __forceinline__ void moe_tile_offsets(Frame& F, int j, int (&toff)[9]) {
    gu32* cnt = F.ctl + CW_ROUTE + j * 64; int acc = 0;
    const unsigned nv = __hip_atomic_load(cnt + (F.lane & 7), RLX_AGENT);
#pragma unroll
    for (int e = 0; e < NEXP; ++e) { toff[e] = acc; const unsigned n = (unsigned)__builtin_amdgcn_readlane((int)nv, e); acc += (int)((n + 255u) >> 8); }
    toff[8] = acc;
}
__device__ __forceinline__ void moe_gather(Frame& F, int j, int L) {
    int toff[9]; moe_tile_offsets(F, j, toff);
    int* r_e = (int*)(F.ws + WS_ROUTE); int* r_pos = r_e + 2 * M;
    unsigned char* XG = F.ws + WS_XG; const bf16* XB = (const bf16*)(F.ws + WS_XB);
    const unsigned long long* ssx = (const unsigned long long*)(F.ws + WS_SS) + (size_t)SS_FFN(L) * M;
    const int gw = F.vcu * NWAVES + F.wave, NGW = F.G * NWAVES;
    const RowLoop rl = row_loop(gw, NGW, 8);
    for (int m0 = rl.start; m0 < rl.end; m0 += rl.step) {
        v4u a[8][2];
        const int re_v = r_e[2 * m0 + (F.lane & 15)], rp_v = r_pos[2 * m0 + (F.lane & 15)]; const float ss_v = (float)ssx[m0 + (F.lane & 7)];
#pragma unroll
        for (int u = 0; u < 8; ++u) { const GAS v4u* src = (const GAS v4u*)(XB + (size_t)(m0 + u) * DM) + 2 * F.lane; a[u][0] = src[0]; a[u][1] = src[1]; }
#pragma unroll
        for (int u = 0; u < 8; ++u) { const int m = m0 + u;
            const float r = __builtin_amdgcn_rsqf(__uint_as_float(__builtin_amdgcn_readlane(__float_as_uint(ss_v), u)) * SS_FX_INV * (1.0f / DM) + NORM_EPS) * MOE_SX;
            v4u b;
            { const v4u w0 = a[u][0], w1 = a[u][1];
              b.x = pk4i8(__uint_as_float(w0.x << 16) * r, __uint_as_float(w0.x & 0xffff0000u) * r, __uint_as_float(w0.y << 16) * r, __uint_as_float(w0.y & 0xffff0000u) * r);
              b.y = pk4i8(__uint_as_float(w0.z << 16) * r, __uint_as_float(w0.z & 0xffff0000u) * r, __uint_as_float(w0.w << 16) * r, __uint_as_float(w0.w & 0xffff0000u) * r);
              b.z = pk4i8(__uint_as_float(w1.x << 16) * r, __uint_as_float(w1.x & 0xffff0000u) * r, __uint_as_float(w1.y << 16) * r, __uint_as_float(w1.y & 0xffff0000u) * r);
              b.w = pk4i8(__uint_as_float(w1.z << 16) * r, __uint_as_float(w1.z & 0xffff0000u) * r, __uint_as_float(w1.w << 16) * r, __uint_as_float(w1.w & 0xffff0000u) * r); }
#pragma unroll
            for (int k = 0; k < 2; ++k) { const int e = __builtin_amdgcn_readlane(re_v, 2 * u + k), pos = __builtin_amdgcn_readlane(rp_v, 2 * u + k); int t0 = 0;
#pragma unroll
                for (int q = 0; q < NEXP; ++q) t0 = (e == q) ? toff[q] : t0;
                const int dest = t0 * 256 + pos;
                ((GAS v4u*)(XG + (size_t)dest * DM))[F.lane] = b;
                if (F.lane == 0) r_pos[2 * m + k] = dest; } }
    }
}
__device__ __forceinline__ void ffn_quant(Frame& F, int ssi) {
    unsigned char* XQ = F.ws + WS_XQ; const bf16* XB = (const bf16*)(F.ws + WS_XB);
    const unsigned long long* ssx = (const unsigned long long*)(F.ws + WS_SS) + (size_t)ssi * M;
    const int gw = F.vcu * NWAVES + F.wave, NGW = F.G * NWAVES;
    const RowLoop rl = row_loop(gw, NGW, 8);
    for (int m0 = rl.start; m0 < rl.end; m0 += rl.step) {
        v4u a[8][2];
        const float ss_v = (float)ssx[m0 + (F.lane & 7)];
#pragma unroll
        for (int u = 0; u < 8; ++u) { const GAS v4u* src = (const GAS v4u*)(XB + (size_t)(m0 + u) * DM) + 2 * F.lane; a[u][0] = src[0]; a[u][1] = src[1]; }
#pragma unroll
        for (int u = 0; u < 8; ++u) { const int m = m0 + u;
            const float r = __builtin_amdgcn_rsqf(__uint_as_float(__builtin_amdgcn_readlane(__float_as_uint(ss_v), u)) * SS_FX_INV * (1.0f / DM) + NORM_EPS) * MOE_SX;
            const v4u w0 = a[u][0], w1 = a[u][1]; v4u b;
            b.x = pk4i8(__uint_as_float(w0.x << 16) * r, __uint_as_float(w0.x & 0xffff0000u) * r, __uint_as_float(w0.y << 16) * r, __uint_as_float(w0.y & 0xffff0000u) * r);
            b.y = pk4i8(__uint_as_float(w0.z << 16) * r, __uint_as_float(w0.z & 0xffff0000u) * r, __uint_as_float(w0.w << 16) * r, __uint_as_float(w0.w & 0xffff0000u) * r);
            b.z = pk4i8(__uint_as_float(w1.x << 16) * r, __uint_as_float(w1.x & 0xffff0000u) * r, __uint_as_float(w1.y << 16) * r, __uint_as_float(w1.y & 0xffff0000u) * r);
            b.w = pk4i8(__uint_as_float(w1.z << 16) * r, __uint_as_float(w1.z & 0xffff0000u) * r, __uint_as_float(w1.w << 16) * r, __uint_as_float(w1.w & 0xffff0000u) * r);
            ((GAS v4u*)(XQ + (size_t)m * DM))[F.lane] = b; }
    }
}
__device__ __forceinline__ void moe_combine(Frame& F, int L, bool last) {
    const int* r_e = (const int*)(F.ws + WS_ROUTE); const int* r_pos = r_e + 2 * M; const float* r_w = (const float*)(r_pos + 2 * M);
    const bf16* YE = (const bf16*)(F.ws + WS_XG);
    unsigned long long* ss = (unsigned long long*)(F.ws + WS_SS) + (size_t)SS_MIXN(last ? 0 : L + 1) * M;
    const float* gfin = (const float*)argt(29);
    const int g = F.lane >> 4, t = F.lane & 15;
    const int gw = F.vcu * NWAVES + F.wave, NGW = F.G * NWAVES;
    int d0n = 0, d1n = 0; float w0n = 0.f, w1n = 0.f;
    const RowLoop rl = row_loop(gw, NGW, 4);
    { const int mf = rl.start + g; if (rl.start < rl.end) { d0n = r_pos[2 * mf]; d1n = r_pos[2 * mf + 1]; w0n = r_w[2 * mf]; w1n = r_w[2 * mf + 1]; } }
    for (int m0 = rl.start; m0 < rl.end; m0 += rl.step) { const int m = m0 + g;
        GAS f32x4* xr = (GAS f32x4*)(F.out + (size_t)m * DM) + t; GAS unsigned long long* xb = (GAS unsigned long long*)((bf16*)(F.ws + WS_XB) + (size_t)m * DM) + t;
        const int d0 = d0n, d1 = d1n; const float w0 = w0n, w1 = w1n;
        { const int mn = m + rl.step; if (m0 + rl.step < rl.end) { d0n = r_pos[2 * mn]; d1n = r_pos[2 * mn + 1]; w0n = r_w[2 * mn]; w1n = r_w[2 * mn + 1]; } }
        const GAS unsigned long long* y0 = (const GAS unsigned long long*)(YE + (size_t)d0 * DM) + t; const GAS unsigned long long* y1 = (const GAS unsigned long long*)(YE + (size_t)d1 * DM) + t;
        f32x4 v[16]; unsigned long long ya[16], yb[16]; float s = 0.f;
#pragma unroll
        for (int i = 0; i < 16; ++i) { const unsigned long long xw = xb[16 * i]; const unsigned a0 = (unsigned)xw, a1 = (unsigned)(xw >> 32);
            v[i] = (f32x4){__uint_as_float(a0 << 16), __uint_as_float(a0 & 0xffff0000u), __uint_as_float(a1 << 16), __uint_as_float(a1 & 0xffff0000u)}; ya[i] = y0[16 * i]; yb[i] = y1[16 * i]; }
#pragma unroll
        for (int i = 0; i < 16; ++i) { const unsigned a0 = (unsigned)ya[i], a1 = (unsigned)(ya[i] >> 32), c0 = (unsigned)yb[i], c1 = (unsigned)(yb[i] >> 32);
            v[i].x += w0 * __uint_as_float(a0 << 16) + w1 * __uint_as_float(c0 << 16);
            v[i].y += w0 * __uint_as_float(a0 & 0xffff0000u) + w1 * __uint_as_float(c0 & 0xffff0000u);
            v[i].z += w0 * __uint_as_float(a1 << 16) + w1 * __uint_as_float(c1 << 16);
            v[i].w += w0 * __uint_as_float(a1 & 0xffff0000u) + w1 * __uint_as_float(c1 & 0xffff0000u);
            s += (v[i].x * v[i].x + v[i].y * v[i].y) + (v[i].z * v[i].z + v[i].w * v[i].w); }
        s = grp16_sum(s);
        if (!last) {
#pragma unroll
            for (int i = 0; i < 16; ++i) xb[16 * i] = (unsigned long long)pk2(v[i].x, v[i].y) | ((unsigned long long)pk2(v[i].z, v[i].w) << 32);
            if (t == 0) ss[m] = (unsigned long long)(s * SS_FX);
            { const float rq = __builtin_amdgcn_rsqf(s * (1.0f / DM) + NORM_EPS) * MOE_SX; GAS unsigned* q4 = (GAS unsigned*)(F.ws + WS_XQ + (size_t)m * DM) + t;
#pragma unroll
              for (int i = 0; i < 16; ++i) q4[16 * i] = pk4i8(v[i].x * rq, v[i].y * rq, v[i].z * rq, v[i].w * rq); }
        } else {
            const float r = 1.0f / sqrtf(s * (1.0f / DM) + NORM_EPS); const GAS f32x4* gf = (const GAS f32x4*)gfin + t;
#pragma unroll
            for (int i = 0; i < 16; ++i) { const f32x4 gq = gf[16 * i]; xr[16 * i] = (f32x4){v[i].x * r * gq.x, v[i].y * r * gq.y, v[i].z * r * gq.z, v[i].w * r * gq.w}; }
        }
    }
}

#ifndef PROBE_SPIN_MASK
#define PROBE_SPIN_MASK 0
#endif

#ifndef PROBE_P02
#define PROBE_P02 0
#endif
#ifndef PROBE_MOE2
#define PROBE_MOE2 0
#endif
#ifndef PROBE_DGU2
#define PROBE_DGU2 0
#endif
#ifndef PROBE_INP2
#define PROBE_INP2 0
#endif

#ifndef PROBE_ATT2
#define PROBE_ATT2 0
#endif
#ifndef PROBE_SSM2
#define PROBE_SSM2 0
#endif

#ifndef EN_ALL
#define EN_ALL 1
#endif
#ifndef EN_P0
#define EN_P0 EN_ALL
#endif
#ifndef EN_INPROJ
#define EN_INPROJ EN_ALL
#endif
#ifndef EN_SSM
#define EN_SSM EN_ALL
#endif
#ifndef EN_GLU
#define EN_GLU EN_ALL
#endif
#ifndef EN_ATT
#define EN_ATT EN_ALL
#endif
#ifndef EN_OUT
#define EN_OUT EN_ALL
#endif
#ifndef EN_DGU
#define EN_DGU EN_ALL
#endif
#ifndef EN_DDN
#define EN_DDN EN_ALL
#endif
#ifndef EN_ROUTE
#define EN_ROUTE EN_ALL
#endif
#ifndef EN_MGU
#define EN_MGU EN_ALL
#endif
#ifndef EN_MDN
#define EN_MDN EN_ALL
#endif

#define PHASE_FN __device__ __forceinline__ void
PHASE_FN ph_prologue() { Frame F = make_frame(); p0_prologue(F); }
PHASE_FN ph_inproj(int L) {
    Frame F = make_frame(); unsigned char* ws = F.ws;
    pg8::Gemm g{(const bf16*)(ws + WS_XQ), (const bf16*)(ws + WS_WIN + (size_t)L * IN_COLS * DM), M, IN_COLS, DM, 0}; pg8::StaticOrder S; S.init(M, IN_COLS, F.G, (int)blockIdx.x, 2);
    pg8::EpiInProj<true> E{(bf16*)(ws + WS_UG), (bf16*)(ws + WS_Q), (size_t)(WS_K - WS_Q) / 2, nullptr, (size_t)(WS_VL - WS_V) / 2, (size_t)(WS_VR - WS_V) / 2, (unsigned*)(F.ctl + CW_KMAX + L * 128), 1.0f / (MOE_SX * MOE_SWGU)};
    static_assert(WS_V - WS_K == WS_K - WS_Q, "q | k | v sections equally spaced");
    pg8::gemm_phase<pg8::EpiInProj<true>, pg8::StaticOrder, true, true, 1>(F.lds + RING_OFF, g, S, E);
}
PHASE_FN ph_ssm(int L) { Frame F = make_frame(); for (int u = blockIdx.x; u < BATCH * SSM_G; u += F.G) ssm_unit(F, L, u); }
PHASE_FN ph_glu(int L) {
    Frame F = make_frame(); unsigned char* ws = F.ws; unsigned long long* SS = (unsigned long long*)(ws + WS_SS);
    pg8::Gemm g{(const bf16*)(ws + WS_Y), (const bf16*)(ws + WS_WGLU) + (size_t)L * SSM_W * SSM_W, M, SSM_W, SSM_W, 0}; pg8::StaticOrder S; S.init(M, SSM_W, F.G, (int)blockIdx.x);
    pg8::EpiGLU E{(const bf16*)(ws + WS_Y), (bf16*)(ws + WS_MIX), (const float*)argt(12) + L * SSM_W, SS + (size_t)SS_GLU(L) * M};
    pg8::gemm_phase<pg8::EpiGLU, pg8::StaticOrder, true, true>(F.lds + RING_OFF, g, S, E);
}
PHASE_FN ph_attn(int L, int rep) { Frame F = make_frame(); attn_phase(F, L, rep); }
PHASE_FN ph_outproj(int L) {
    Frame F = make_frame(); unsigned char* ws = F.ws; unsigned long long* SS = (unsigned long long*)(ws + WS_SS);
    pg8::Gemm g{(const bf16*)(ws + WS_MIX), (const bf16*)(ws + WS_WOUT) + (size_t)L * DM * DM, M, DM, DM, 0}; pg8::StaticOrder S; S.init(M, DM, F.G, (int)blockIdx.x);
    pg8::EpiResid<false> E{(bf16*)(ws + WS_XB), SS + (size_t)SS_GLU(L) * M, 1.0f / SSM_W, SS + (size_t)SS_FFN(L) * M, 1.0f};
    pg8::gemm_phase<pg8::EpiResid<false>, pg8::StaticOrder, true, true>(F.lds + RING_OFF, g, S, E);
}
PHASE_FN ph_quant(int ssi) { Frame F = make_frame(); ffn_quant(F, ssi); }
PHASE_FN ph_dense_gu(int L) {
    Frame F = make_frame(); unsigned char* ws = F.ws; const int j = L >> 1;
    pg8::Gemm g{(const bf16*)(ws + WS_XQ), (const bf16*)(ws + WS_DGU + (size_t)j * (2 * DFF_P) * DM), M, 2 * DFF_P, DM, 0}; pg8::StaticOrder S; S.init(M, 2 * DFF_P, F.G, (int)blockIdx.x);
    pg8::EpiGateUp8<true> E{ws + WS_HD, DFF_P, 1.0f / (MOE_SX * MOE_SWGU), DEN_SH};
    pg8::gemm_phase<pg8::EpiGateUp8<true>, pg8::StaticOrder, true, true, 1>(F.lds + RING_OFF, g, S, E);
}
PHASE_FN ph_dense_dn(int L) {
    Frame F = make_frame(); unsigned char* ws = F.ws; unsigned long long* SS = (unsigned long long*)(ws + WS_SS); const int j = L >> 1;
    pg8::Gemm g{(const bf16*)(ws + WS_HD), (const bf16*)(ws + WS_DDN + (size_t)j * DM * DFF_P), M, DM, DFF_P, 0}; pg8::StaticOrder S; S.init(M, DM, F.G, (int)blockIdx.x);
    pg8::EpiResid<true> E{(bf16*)(ws + WS_XB), nullptr, 0.f, SS + (size_t)SS_MIXN(L + 1) * M, 1.0f / (DEN_SH * DEN_SWDN)};
    pg8::gemm_phase<pg8::EpiResid<true>, pg8::StaticOrder, true, true, 1>(F.lds + RING_OFF, g, S, E);
}
PHASE_FN ph_route(int j) { Frame F = make_frame(); moe_route(F, j); }
PHASE_FN ph_gather(int j, int L) { Frame F = make_frame(); moe_gather(F, j, L); }
PHASE_FN ph_moe_gu(int j, int ch) {
    Frame F = make_frame(); unsigned char* ws = F.ws;
    pg8::ChunkOrder S; int toff[9]; moe_tile_offsets(F, j, toff);
    { LAS int* tl = (LAS int*)(F.lds + LDSCTL_OFF + 3072); __syncthreads(); if (F.tid < 9) { int v = 0;
#pragma unroll
        for (int q = 0; q < 9; ++q) v = (F.tid == q) ? toff[q] : v;
        tl[F.tid] = v; } LDS_WAIT(); __syncthreads(); S.toff = tl; }
    const int tlo = ch * HM_TILES, thi = (toff[8] < tlo + HM_TILES) ? toff[8] : tlo + HM_TILES, nT = thi > tlo ? thi - tlo : 0;
    S.nM = nT; S.nN = (2 * DFE) / 256; S.nwg = S.nM * S.nN; S.G = F.G; S.c = (int)blockIdx.x; S.tlo = tlo;
    pg8::Gemm g{(const bf16*)(ws + WS_XG), (const bf16*)(ws + WS_MGU + (size_t)j * NEXP * (2 * DFE) * DM), MOE_ROWS, 2 * DFE, DM, (size_t)(2 * DFE) * DM};
    pg8::EpiGateUp8<true> E{ws + WS_HM - (size_t)tlo * 256 * DFE, DFE, 1.0f / (MOE_SX * MOE_SWGU), MOE_SH};
    pg8::gemm_phase<pg8::EpiGateUp8<true>, pg8::ChunkOrder, true, true, 1>(F.lds + RING_OFF, g, S, E);
}
PHASE_FN ph_moe_dn(int j, int ch) {
    Frame F = make_frame(); unsigned char* ws = F.ws;
    pg8::ChunkOrder S; int toff[9]; moe_tile_offsets(F, j, toff);
    { LAS int* tl = (LAS int*)(F.lds + LDSCTL_OFF + 3072); __syncthreads(); if (F.tid < 9) { int v = 0;
#pragma unroll
        for (int q = 0; q < 9; ++q) v = (F.tid == q) ? toff[q] : v;
        tl[F.tid] = v; } LDS_WAIT(); __syncthreads(); S.toff = tl; }
    const int tlo = ch * HM_TILES, thi = (toff[8] < tlo + HM_TILES) ? toff[8] : tlo + HM_TILES, nT = thi > tlo ? thi - tlo : 0;
    S.nM = nT; S.nN = DM / 256; S.nwg = S.nM * S.nN; S.G = F.G; S.c = (int)blockIdx.x; S.tlo = tlo;
    pg8::Gemm g{(const bf16*)(ws + WS_HM - (size_t)tlo * 256 * DFE), (const bf16*)(ws + WS_MDN + (size_t)j * NEXP * DM * DFE), MOE_ROWS, DM, DFE, (size_t)DM * DFE};
    pg8::EpiStoreBf16<true> E{(bf16*)(ws + WS_XG), DM, 1.0f / (MOE_SH * MOE_SWDN)};
    pg8::gemm_phase<pg8::EpiStoreBf16<true>, pg8::ChunkOrder, true, true, 1>(F.lds + RING_OFF, g, S, E);
}
PHASE_FN ph_combine(int L) { Frame F = make_frame(); moe_combine(F, L, L == DEPTH - 1); }

constexpr int N_PHASE_IDS = 1 + 12 * DEPTH;
__global__ void __launch_bounds__(NWAVES * 64, 2) fwd_kernel(Args args) {
    LAS unsigned char* lds = (LAS unsigned char*)g_lds;
    for (int u = threadIdx.x; u < (LDS_BYTES - LDSCTL_OFF) / 4; u += NWAVES * 64) ((LAS unsigned*)(lds + LDSCTL_OFF))[u] = 0u;
    __syncthreads();
    if (threadIdx.x < 32) { unsigned long long v;
        if (threadIdx.x < 30) v = (unsigned long long)args.in[threadIdx.x < 30 ? threadIdx.x : 0]; else if (threadIdx.x == 30) v = (unsigned long long)args.out; else v = (unsigned long long)args.ws;
        ((LAS unsigned long long*)(lds + ARGT_OFF))[threadIdx.x] = v; }
    __syncthreads();
    XcdBarrier bar = xcd_barrier_post((unsigned*)((gu32*)(args.ws + WS_CTL) + CW_BAR), (volatile LAS unsigned*)(lds + MISC_OFF) + 8);
    const int lo = args.ph_lo, hi = args.ph_hi;
#define IN(k) (lo <= (k) && (k) < hi)
#define SEAM(k) do { if (hi > (k) + 1) xcd_barrier(bar); } while (0)
#define PH(kind, ...) do { const unsigned long long t0_ = (PROBE_SPIN_MASK >> (kind)) & 1 ? rt() : 0ull; __VA_ARGS__; \
    if ((PROBE_SPIN_MASK >> (kind)) & 1) probe_acc += rt() - t0_; } while (0)
    unsigned long long probe_acc = 0ull;
    if (EN_P0 && IN(0)) PH(1, ph_prologue(); if (PROBE_P02) ph_prologue(); SEAM(0));
#pragma unroll 1
    for (int L = 0; L < DEPTH; ++L) {
        const int pb = 1 + 12 * L;
        if (EN_INPROJ && IN(pb + 0)) PH(2, ph_inproj(L); if (PROBE_INP2) ph_inproj(L); SEAM(pb + 0));
        if (EN_SSM && IN(pb + 1)) PH(3, ph_ssm(L); if (PROBE_SSM2) ph_ssm(L); SEAM(pb + 1));
        if (EN_GLU && IN(pb + 2)) PH(4, ph_glu(L); SEAM(pb + 2));
        if (EN_ATT && IN(pb + 3)) PH(5, ph_attn(L, 0); if (PROBE_ATT2) ph_attn(L, 1); SEAM(pb + 3));
        if (EN_OUT && IN(pb + 4)) PH(6, ph_outproj(L); SEAM(pb + 4));
        if ((L & 1) == 0) {
            if (EN_DGU && IN(pb + 5)) PH(9, ph_quant(SS_FFN(L)); SEAM(pb + 5));
            if (EN_DGU && IN(pb + 6)) PH(7, ph_dense_gu(L); if (PROBE_DGU2) ph_dense_gu(L); SEAM(pb + 6));
            if (EN_DDN && IN(pb + 7)) PH(8, ph_dense_dn(L); SEAM(pb + 7));
            if (EN_DDN && IN(pb + 8)) PH(9, ph_quant(SS_MIXN(L + 1)); SEAM(pb + 8));
        } else {
            const int j = L >> 1;
            if (EN_ROUTE && IN(pb + 5)) PH(9, ph_route(j); SEAM(pb + 5));
            if (EN_ROUTE && IN(pb + 6)) PH(10, ph_gather(j, L); SEAM(pb + 6));
#pragma unroll 1
            for (int ch = 0; ch < 1; ++ch) {
                if (EN_MGU && IN(pb + 7 + 2 * ch)) PH(11, ph_moe_gu(j, ch); if (PROBE_MOE2) ph_moe_gu(j, ch); SEAM(pb + 7 + 2 * ch));
                if (EN_MDN && IN(pb + 8 + 2 * ch)) PH(12, ph_moe_dn(j, ch); if (PROBE_MOE2) ph_moe_dn(j, ch); SEAM(pb + 8 + 2 * ch));
            }
            if (EN_ROUTE && IN(pb + 11)) PH(13, ph_combine(L); SEAM(pb + 11));
        }
    }
    if (PROBE_SPIN_MASK) { const unsigned long long t1_ = rt(); while (rt() - t1_ < probe_acc) __builtin_amdgcn_s_sleep(8); }
#undef IN
#undef SEAM
#undef PH
}

extern "C" void kernel_launch(void* const* d_in, const int* in_sizes, int n_in, void* d_out, int out_size, void* d_ws, size_t ws_size, hipStream_t stream) {
    static int grid = 0;
    if (grid == 0) {
        if (n_in != 30 || in_sizes[0] != M * DM || out_size != M * DM || ws_size < WS_END) {
            fprintf(stderr, "kernel_launch: unexpected shapes (n_in %d, in0 %d, out %d, ws %zu; need ws >= %zu); nothing launched\n", n_in, n_in > 0 ? in_sizes[0] : -1, out_size, ws_size, (size_t)WS_END); grid = -1; return; }
        int dev = 0, cus = 0, per_cu = 0;
        if (hipGetDevice(&dev) != hipSuccess || hipDeviceGetAttribute(&cus, hipDeviceAttributeMultiprocessorCount, dev) != hipSuccess) { grid = -1; return; }
        if (hipFuncSetAttribute((const void*)fwd_kernel, hipFuncAttributeMaxDynamicSharedMemorySize, LDS_BYTES) != hipSuccess) { fprintf(stderr, "kernel_launch: hipFuncSetAttribute failed\n"); grid = -1; return; }
        if (hipOccupancyMaxActiveBlocksPerMultiprocessor(&per_cu, (const void*)fwd_kernel, NWAVES * 64, LDS_BYTES) != hipSuccess || per_cu < 1) { fprintf(stderr, "kernel_launch: occupancy query says %d\n", per_cu); }
        (void)hipGetLastError();
        grid = cus;
    }
    if (grid < 0) return;
    (void)hipMemsetAsync((char*)d_ws, 0, ZERO_BYTES, stream);
    Args a{};
    for (int i = 0; i < 30; ++i) a.in[i] = (const float*)d_in[i];
    a.out = (float*)d_out; a.ws = (unsigned char*)d_ws;
#ifndef MK_ONE_LAUNCH
#define MK_ONE_LAUNCH 1
#endif
    if (MK_ONE_LAUNCH) { a.ph_lo = 0; a.ph_hi = N_PHASE_IDS; hipLaunchKernelGGL(fwd_kernel, dim3(grid), dim3(NWAVES * 64), LDS_BYTES, stream, a); }
    else {
        for (int p = 0; p < N_PHASE_IDS; ++p) {
            if (p > 0) { const int L = (p - 1) / 12, k = (p - 1) % 12; if ((L & 1) == 0 && k >= 9) continue; }
            a.ph_lo = p; a.ph_hi = p + 1;
            hipLaunchKernelGGL(fwd_kernel, dim3(grid), dim3(NWAVES * 64), LDS_BYTES, stream, a);
        }
    }
    const hipError_t le = hipPeekAtLastError();
    if (le != hipSuccess) fprintf(stderr, "kernel_launch: launch failed: %s\n", hipGetErrorName(le));
}
```
